# Optimizing an MI355X kernel written in HIP

```python
import math
import jax, jax.numpy as jnp
from jax import lax
import numpy as np

D_MODEL = 2048
BATCH = 8
SEQ = 2048
DEPTH = 1

HYENA_WIDTH = 1024
CONV_WIDTH = 3
FILTER_EMB_DIM = 33
FILTER_HIDDEN = 64
DECAY_TARGET = 1e-2
FAST_DECAY_PCT = 0.3
SLOW_DECAY_PCT = 1.5
DECAY_SHIFT = 0.05

N_HEADS = 8
QK_NOPE_DIM = 128
QK_ROPE_DIM = 64
V_HEAD_DIM = 128
Q_LORA_RANK = 512
KV_LORA_RANK = 256
ROPE_THETA = 10000.0
Q_BLOCK = 128

ATTN_WIDTH = N_HEADS * V_HEAD_DIM
MIX_WIDTH = HYENA_WIDTH + ATTN_WIDTH
IN_PROJ_WIDTH = 3 * HYENA_WIDTH + Q_LORA_RANK + KV_LORA_RANK + QK_ROPE_DIM

D_FF = 5632
NORM_EPS = 1e-6

kernel_name = "hybrid_hyena_mla_convffn_sandwich"


def _rmsnorm(x, gain):
    xf = x.astype(jnp.float32)
    y = xf * lax.rsqrt(jnp.mean(xf * xf, axis=-1, keepdims=True) + NORM_EPS)
    return (y * gain.astype(jnp.float32)).astype(x.dtype)


def _dwconv_centred(x, w, b):
    k = w.shape[0]
    half = k // 2
    s = x.shape[1]
    xp = jnp.pad(x, ((0, 0), (half, half), (0, 0)))
    return sum(xp[:, j:j + s] * w[j] for j in range(k)) + b


def _position_features(L):
    t = jnp.linspace(0.0, 1.0, L, dtype=jnp.float32)[:, None]
    bands = (FILTER_EMB_DIM - 1) // 2
    w = 2.0 * math.pi * jnp.arange(L, dtype=jnp.float32) / L
    f = jnp.linspace(1e-4, bands - 1, bands, dtype=jnp.float32)
    ang = w[:, None] * f[None, :]
    return t, jnp.concatenate([t, jnp.cos(ang), -jnp.sin(ang)], axis=-1)


def _implicit_filters(t, z, w1, b1, fr1, w2, b2, fr2, w3):
    f32 = jnp.float32
    L = t.shape[0]
    h = jnp.sin(fr1.astype(f32) * (z @ w1.astype(f32) + b1.astype(f32)))
    h = jnp.sin(fr2.astype(f32) * (h @ w2.astype(f32) + b2.astype(f32)))
    h = h @ w3.astype(f32)
    max_decay = math.log(DECAY_TARGET) / FAST_DECAY_PCT
    min_decay = math.log(DECAY_TARGET) / SLOW_DECAY_PCT
    deltas = jnp.abs(jnp.linspace(min_decay, max_decay, HYENA_WIDTH, dtype=f32))
    window = jnp.exp(-t * deltas[None, :]) + DECAY_SHIFT
    h = h.reshape(L, 2, HYENA_WIDTH) * window[:, None, :]
    h_fwd, h_bwd = h[:, 0], h[:, 1]
    return jnp.concatenate([h_fwd, jnp.zeros((1, HYENA_WIDTH), f32), h_bwd[1:][::-1]], axis=0)


def _bidir_long_conv(u, k2, bias):
    L = u.shape[1]
    n = 2 * L
    uf = jnp.fft.rfft(u.astype(jnp.float32), n=n, axis=1)
    kf = jnp.fft.rfft(k2, n=n, axis=0)
    y = jnp.fft.irfft(uf * kf[None], n=n, axis=1)[:, :L]
    return (y + u.astype(jnp.float32) * bias.astype(jnp.float32)).astype(u.dtype)


def _rope(x, cos, sin):
    x1, x2 = jnp.split(x, 2, axis=-1)
    return x * cos + jnp.concatenate([-x2, x1], axis=-1) * sin


def _mla(c_q, c_kv, k_pe, q_norm_gain, w_uq, kv_norm_gain, w_ukv, cos, sin):
    B, S, _ = c_q.shape
    dqk = QK_NOPE_DIM + QK_ROPE_DIM
    q = (_rmsnorm(c_q, q_norm_gain) @ w_uq).reshape(B, S, N_HEADS, dqk)
    q_nope, q_pe = q[..., :QK_NOPE_DIM], q[..., QK_NOPE_DIM:]
    kv = (_rmsnorm(c_kv, kv_norm_gain) @ w_ukv).reshape(B, S, N_HEADS, QK_NOPE_DIM + V_HEAD_DIM)
    k_nope, v = kv[..., :QK_NOPE_DIM], kv[..., QK_NOPE_DIM:]
    q_pe = _rope(q_pe, cos[:, None, :], sin[:, None, :])
    k_pe = _rope(k_pe, cos, sin)
    q = jnp.concatenate([q_nope, q_pe], axis=-1)
    k = jnp.concatenate([k_nope, jnp.broadcast_to(k_pe[:, :, None, :], (B, S, N_HEADS, QK_ROPE_DIM))], axis=-1)
    scale = dqk ** -0.5
    nb = S // Q_BLOCK
    qb = q.reshape(B, nb, Q_BLOCK, N_HEADS, dqk).transpose(1, 0, 2, 3, 4)

    def attend(q_blk):
        s = jnp.einsum('bqhd,bkhd->bhqk', q_blk, k).astype(jnp.float32) * scale
        p = jax.nn.softmax(s, axis=-1).astype(v.dtype)
        return jnp.einsum('bhqk,bkhd->bqhd', p, v)

    o = lax.map(attend, qb)
    return o.transpose(1, 0, 2, 3, 4).reshape(B, S, ATTN_WIDTH)


def setup_inputs(seed: int = 0) -> dict:
    key = jax.random.key(seed)
    ks = jax.random.split(key, 32)
    f32 = jnp.float32

    def nrm(k, shape, scale):
        return jax.random.normal(k, shape, f32) * scale

    def gain(k, n):
        return 1.0 + 0.05 * jax.random.normal(k, (DEPTH, n), f32)

    return {
        "x": nrm(ks[0], (BATCH, SEQ, D_MODEL), 1.0),
        "pre_mix_gain": gain(ks[1], D_MODEL),
        "w_in": nrm(ks[2], (DEPTH, D_MODEL, IN_PROJ_WIDTH), D_MODEL ** -0.5),
        "hyena_conv_w": nrm(ks[3], (DEPTH, CONV_WIDTH, 3 * HYENA_WIDTH), CONV_WIDTH ** -0.5),
        "hyena_conv_b": nrm(ks[4], (DEPTH, 3 * HYENA_WIDTH), 0.02),
        "filt_w1": nrm(ks[5], (DEPTH, FILTER_EMB_DIM, FILTER_HIDDEN), FILTER_EMB_DIM ** -0.5),
        "filt_b1": nrm(ks[6], (DEPTH, FILTER_HIDDEN), 0.02),
        "filt_freq1": 1.0 + 0.1 * jax.random.normal(ks[7], (DEPTH, FILTER_HIDDEN), f32),
        "filt_w2": nrm(ks[8], (DEPTH, FILTER_HIDDEN, FILTER_HIDDEN), FILTER_HIDDEN ** -0.5),
        "filt_b2": nrm(ks[9], (DEPTH, FILTER_HIDDEN), 0.02),
        "filt_freq2": 1.0 + 0.1 * jax.random.normal(ks[10], (DEPTH, FILTER_HIDDEN), f32),
        "filt_w3": nrm(ks[11], (DEPTH, FILTER_HIDDEN, 2 * HYENA_WIDTH), FILTER_HIDDEN ** -0.5),
        "hyena_bias": nrm(ks[12], (DEPTH, HYENA_WIDTH), 0.5),
        "q_norm_gain": gain(ks[13], Q_LORA_RANK),
        "w_uq": nrm(ks[14], (DEPTH, Q_LORA_RANK, N_HEADS * (QK_NOPE_DIM + QK_ROPE_DIM)), Q_LORA_RANK ** -0.5),
        "kv_norm_gain": gain(ks[15], KV_LORA_RANK),
        "w_ukv": nrm(ks[16], (DEPTH, KV_LORA_RANK, N_HEADS * (QK_NOPE_DIM + V_HEAD_DIM)), KV_LORA_RANK ** -0.5),
        "hyena_out_gain": gain(ks[17], HYENA_WIDTH),
        "attn_out_gain": gain(ks[18], ATTN_WIDTH),
        "w_out": nrm(ks[19], (DEPTH, MIX_WIDTH, D_MODEL), MIX_WIDTH ** -0.5),
        "post_mix_gain": gain(ks[20], D_MODEL),
        "pre_ffn_gain": gain(ks[21], D_MODEL),
        "w_up": nrm(ks[22], (DEPTH, D_MODEL, 2 * D_FF), D_MODEL ** -0.5),
        "ffn_conv_w": nrm(ks[23], (DEPTH, CONV_WIDTH, D_FF), CONV_WIDTH ** -0.5),
        "ffn_conv_b": nrm(ks[24], (DEPTH, D_FF), 0.02),
        "w_down": nrm(ks[25], (DEPTH, D_FF, D_MODEL), D_FF ** -0.5),
        "post_ffn_gain": gain(ks[26], D_MODEL),
    }


def reference(x, pre_mix_gain, w_in, hyena_conv_w, hyena_conv_b, filt_w1, filt_b1, filt_freq1,
              filt_w2, filt_b2, filt_freq2, filt_w3, hyena_bias, q_norm_gain, w_uq, kv_norm_gain,
              w_ukv, hyena_out_gain, attn_out_gain, w_out, post_mix_gain, pre_ffn_gain, w_up,
              ffn_conv_w, ffn_conv_b, w_down, post_ffn_gain):
    B, S, _ = x.shape
    pos = jnp.arange(S, dtype=jnp.float32)
    inv_freq = 1.0 / (ROPE_THETA ** (jnp.arange(0, QK_ROPE_DIM, 2, dtype=jnp.float32) / QK_ROPE_DIM))
    ang = pos[:, None] * inv_freq[None, :]
    ang = jnp.concatenate([ang, ang], axis=-1)
    cos = jnp.cos(ang).astype(x.dtype)
    sin = jnp.sin(ang).astype(x.dtype)
    t, z = _position_features(S)

    h = x
    for l in range(DEPTH):
        xn = _rmsnorm(h, pre_mix_gain[l])
        proj = xn @ w_in[l]
        o1 = 3 * HYENA_WIDTH
        o2 = o1 + Q_LORA_RANK
        o3 = o2 + KV_LORA_RANK
        xh, c_q, c_kv, k_pe = proj[..., :o1], proj[..., o1:o2], proj[..., o2:o3], proj[..., o3:]

        xh = _dwconv_centred(xh, hyena_conv_w[l], hyena_conv_b[l])
        x0 = xh[..., :HYENA_WIDTH]
        x1 = xh[..., HYENA_WIDTH:2 * HYENA_WIDTH]
        v = xh[..., 2 * HYENA_WIDTH:]
        k2 = _implicit_filters(t, z, filt_w1[l], filt_b1[l], filt_freq1[l], filt_w2[l], filt_b2[l],
                               filt_freq2[l], filt_w3[l])
        y_hyena = x0 * _bidir_long_conv(x1 * v, k2, hyena_bias[l])

        y_attn = _mla(c_q, c_kv, k_pe, q_norm_gain[l], w_uq[l], kv_norm_gain[l], w_ukv[l], cos, sin)

        mixed = jnp.concatenate([_rmsnorm(y_hyena, hyena_out_gain[l]),
                                 _rmsnorm(y_attn, attn_out_gain[l])], axis=-1) @ w_out[l]
        h = h + _rmsnorm(mixed, post_mix_gain[l])

        hn = _rmsnorm(h, pre_ffn_gain[l])
        gu = hn @ w_up[l]
        g = _dwconv_centred(gu[..., :D_FF], ffn_conv_w[l], ffn_conv_b[l])
        u = gu[..., D_FF:]
        f = (jax.nn.gelu(g, approximate=True) * u) @ w_down[l]
        h = h + _rmsnorm(f, post_ffn_gain[l])
    return h
```

```cpp
#include <hip/hip_runtime.h>
#include <hip/hip_cooperative_groups.h>
#include <cstdio>
#include <cstdint>
namespace cg = cooperative_groups;
#ifndef MK_N_LAUNCHES
#define MK_N_LAUNCHES 1
#endif
namespace pg8 {
#define PG8_LAS __attribute__((address_space(3)))
typedef unsigned short bf16_t;
typedef short bf16x8 __attribute__((ext_vector_type(8)));
typedef float f32x4 __attribute__((ext_vector_type(4)));
typedef unsigned u32x4 __attribute__((ext_vector_type(4)));
constexpr int BM = 256, BK = 64, HALF = 128, HTB = HALF * BK * 2  , STAGE_BYTES = 8 * HTB, NXCD = 8, WGM = 8;

__host__ __device__ __forceinline__ int lds_byte(int r, int c) { const int st = (r >> 4) * 2 + (c >> 5), rr = r & 15, cc = c & 31, ob = rr * 64 + cc * 2; return st * 1024 + (ob ^ (((ob >> 9) & 1) << 5)); }
__host__ __device__ __forceinline__ void stage_rc(int b, int& R, int& C) { const int st = b / 1024, sb = b % 1024, swz = sb ^ (((sb >> 9) & 1) << 5); R = (st >> 1) * 16 + swz / 64; C = (st & 1) * 32 + (swz % 64) / 2; }
__host__ __device__ __forceinline__ int perm32(int rho) { const int n = rho >> 4, i = rho & 15; return 8 * (i >> 2) + 4 * n + (i & 3); }

struct Unit { int pm, pn; };
struct Gemm { const bf16_t* A; const bf16_t* Bt; int M, N, K; };

struct StaticOrder {
    int nM, nN, nwg, G, c;
    __host__ __device__ void init(int M, int N, int G_, int c_) { nM = M / BM; nN = N / BM; nwg = nM * nN; G = G_; c = c_; }
    __host__ __device__ bool next(int i, Unit& u) const {
        const long L = (long)i * G + c; if (L >= nwg) return false;
        int wgid = (int)L; { const int q = nwg / NXCD, r = nwg % NXCD, xcd = wgid % NXCD, off = wgid / NXCD; wgid = (xcd < r ? xcd * (q + 1) : r * (q + 1) + (xcd - r) * q) + off; }
        const int nig = WGM * nN, gid = wgid / nig, fm = gid * WGM, gsz = (nM - fm) < WGM ? (nM - fm) : WGM;
        u.pm = fm + ((wgid % nig) % gsz); u.pn = (wgid % nig) / gsz; return true;
    }
    __device__ __forceinline__ void a_ready(const Unit&) const {}
    __device__ __forceinline__ void done(const Unit&) const {}
};

__device__ __forceinline__ unsigned cvt_pk_bf16(float lo, float hi) { unsigned r; asm volatile("v_cvt_pk_bf16_f32 %0, %1, %2" : "=v"(r) : "v"(lo), "v"(hi)); return r; }
typedef float f32x2 __attribute__((ext_vector_type(2)));

struct EpiStore {
    static constexpr bool PERM = true, AFTER_DRAIN = false;
    bf16_t* O; int ldc; bool nt = false;
    __device__ __forceinline__ void operator()(const f32x4 (&acc)[2][2][4][2], const Unit& u, int wr, int wc, int fr, int fq) const {
        const int row0 = u.pm * BM + wr * 64 + fr; const int col0 = u.pn * BM + wc * 32 + 8 * fq;
#pragma unroll
        for (int ai = 0; ai < 2; ++ai)
#pragma unroll
            for (int m = 0; m < 4; ++m) { bf16_t* rowp = O + (size_t)(row0 + ai * HALF + m * 16) * ldc + col0;
#pragma unroll
                for (int bj = 0; bj < 2; ++bj) { const f32x4 v0 = acc[ai][bj][m][0], v1 = acc[ai][bj][m][1];
                    u32x4 w; w.x = cvt_pk_bf16(v0[0], v0[1]); w.y = cvt_pk_bf16(v0[2], v0[3]); w.z = cvt_pk_bf16(v1[0], v1[1]); w.w = cvt_pk_bf16(v1[2], v1[3]);
                    if (nt) __builtin_nontemporal_store(w, (u32x4*)(rowp + bj * HALF)); else *(u32x4*)(rowp + bj * HALF) = w; } }
    }
};

struct EpiMixRes {
    static constexpr bool PERM = true, AFTER_DRAIN = false;
    bf16_t* MIXED; const float* x; const float* gpost; bf16_t* H16; float* SS1; float* SS2; unsigned* CNT; int ldc; float eps;
    __device__ __forceinline__ void fin8(const f32x4& v0, const f32x4& v1, float r1, size_t o, int col, float& s2) const {
        const f32x4 x0 = __builtin_nontemporal_load((const f32x4*)(x + o)), x1 = __builtin_nontemporal_load((const f32x4*)(x + o + 4)), g0 = *(const f32x4*)(gpost + col), g1 = *(const f32x4*)(gpost + col + 4);
        const f32x4 h0 = x0 + (v0 * r1) * g0, h1 = x1 + (v1 * r1) * g1;
        s2 += (h0[0] * h0[0] + h0[1] * h0[1]) + (h0[2] * h0[2] + h0[3] * h0[3]) + (h1[0] * h1[0] + h1[1] * h1[1]) + (h1[2] * h1[2] + h1[3] * h1[3]);
        u32x4 w; w.x = cvt_pk_bf16(h0[0], h0[1]); w.y = cvt_pk_bf16(h0[2], h0[3]); w.z = cvt_pk_bf16(h1[0], h1[1]); w.w = cvt_pk_bf16(h1[2], h1[3]);
        *(u32x4*)(H16 + o) = w;
    }
    __device__ __forceinline__ void operator()(const f32x4 (&acc)[2][2][4][2], const Unit& u, int wr, int wc, int fr, int fq) const {
        const bool second = (u.pn >= 4);
        const int row0 = u.pm * BM + wr * 64 + fr; const int col0 = u.pn * BM + wc * 32 + 8 * fq;
#pragma unroll
        for (int ai = 0; ai < 2; ++ai)
#pragma unroll
            for (int m = 0; m < 4; ++m) { float s = 0.f;
#pragma unroll
                for (int bj = 0; bj < 2; ++bj)
#pragma unroll
                    for (int n = 0; n < 2; ++n) { const f32x4 v = acc[ai][bj][m][n]; s += (v[0] * v[0] + v[1] * v[1]) + (v[2] * v[2] + v[3] * v[3]); }
                s += __shfl_xor(s, 16); s += __shfl_xor(s, 32);
                if (fq == 0) (void)__hip_atomic_fetch_add(SS1 + row0 + ai * HALF + m * 16, s, __ATOMIC_RELAXED, __HIP_MEMORY_SCOPE_AGENT); }
        if (!second) {
#pragma unroll
            for (int ai = 0; ai < 2; ++ai)
#pragma unroll
                for (int m = 0; m < 4; ++m) { bf16_t* rowp = MIXED + (size_t)(row0 + ai * HALF + m * 16) * ldc + col0;
#pragma unroll
                    for (int bj = 0; bj < 2; ++bj) { const f32x4 v0 = acc[ai][bj][m][0], v1 = acc[ai][bj][m][1];
                        u32x4 w; w.x = cvt_pk_bf16(v0[0], v0[1]); w.y = cvt_pk_bf16(v0[2], v0[3]); w.z = cvt_pk_bf16(v1[0], v1[1]); w.w = cvt_pk_bf16(v1[2], v1[3]);
                        *(u32x4*)(rowp + bj * HALF) = w; } }
            return;
        }
        asm volatile("s_waitcnt vmcnt(0)" ::: "memory");
        __builtin_amdgcn_s_barrier();
        if (threadIdx.x == 0) {
            __builtin_amdgcn_fence(__ATOMIC_RELEASE, "agent");
            (void)__hip_atomic_fetch_add(CNT + 64 * u.pm, 1u, __ATOMIC_RELAXED, __HIP_MEMORY_SCOPE_AGENT);
            unsigned sp = 0;
            while (__hip_atomic_load(CNT + 64 * u.pm, __ATOMIC_RELAXED, __HIP_MEMORY_SCOPE_AGENT) < 4u) { __builtin_amdgcn_s_sleep(2); if (++sp > (1u << 22)) break; }
            __builtin_amdgcn_fence(__ATOMIC_ACQUIRE, "agent");
        }
        __builtin_amdgcn_s_barrier();
        asm volatile("" ::: "memory");
#pragma unroll
        for (int ai = 0; ai < 2; ++ai)
#pragma unroll
            for (int m = 0; m < 4; ++m) { const int row = row0 + ai * HALF + m * 16;
                const float r1 = 1.f / sqrtf(__hip_atomic_load(SS1 + row, __ATOMIC_RELAXED, __HIP_MEMORY_SCOPE_AGENT) * (1.f / 2048.f) + eps);
                float s2 = 0.f;
#pragma unroll
                for (int bj = 0; bj < 2; ++bj) {
                    const int col = col0 + bj * HALF; const size_t o = (size_t)row * ldc + col;
                    fin8(acc[ai][bj][m][0], acc[ai][bj][m][1], r1, o, col, s2);
                    const int colp = col - 4 * BM; const size_t op = (size_t)row * ldc + colp;
                    const u32x4 w = *(const u32x4*)(MIXED + op);
                    const f32x4 p0 = {__builtin_bit_cast(float, w.x << 16), __builtin_bit_cast(float, w.x & 0xffff0000u), __builtin_bit_cast(float, w.y << 16), __builtin_bit_cast(float, w.y & 0xffff0000u)};
                    const f32x4 p1 = {__builtin_bit_cast(float, w.z << 16), __builtin_bit_cast(float, w.z & 0xffff0000u), __builtin_bit_cast(float, w.w << 16), __builtin_bit_cast(float, w.w & 0xffff0000u)};
                    fin8(p0, p1, r1, op, colp, s2); }
                s2 += __shfl_xor(s2, 16); s2 += __shfl_xor(s2, 32);
                if (fq == 0) (void)__hip_atomic_fetch_add(SS2 + row, s2, __ATOMIC_RELAXED, __HIP_MEMORY_SCOPE_AGENT); }
    }
};

struct EpiFinal {
    static constexpr bool PERM = true, AFTER_DRAIN = false;
    bf16_t* FB; const bf16_t* H16; const float* gain; float* out; float* SS; unsigned* CNT; int ldc; float eps;
    __device__ __forceinline__ void fin8(const f32x4& v0, const f32x4& v1, float r, size_t o, int col) const {
        const u32x4 hw = __builtin_nontemporal_load((const u32x4*)(H16 + o)); const f32x4 g0 = *(const f32x4*)(gain + col), g1 = *(const f32x4*)(gain + col + 4);
        const f32x4 h0 = {__builtin_bit_cast(float, hw.x << 16), __builtin_bit_cast(float, hw.x & 0xffff0000u), __builtin_bit_cast(float, hw.y << 16), __builtin_bit_cast(float, hw.y & 0xffff0000u)};
        const f32x4 h1 = {__builtin_bit_cast(float, hw.z << 16), __builtin_bit_cast(float, hw.z & 0xffff0000u), __builtin_bit_cast(float, hw.w << 16), __builtin_bit_cast(float, hw.w & 0xffff0000u)};
        __builtin_nontemporal_store(h0 + (v0 * r) * g0, (f32x4*)(out + o)); __builtin_nontemporal_store(h1 + (v1 * r) * g1, (f32x4*)(out + o + 4));
    }
    __device__ __forceinline__ void operator()(const f32x4 (&acc)[2][2][4][2], const Unit& u, int wr, int wc, int fr, int fq) const {
        const bool second = (u.pn >= 4);
        const int row0 = u.pm * BM + wr * 64 + fr; const int col0 = u.pn * BM + wc * 32 + 8 * fq;
#pragma unroll
        for (int ai = 0; ai < 2; ++ai)
#pragma unroll
            for (int m = 0; m < 4; ++m) { float s = 0.f;
#pragma unroll
                for (int bj = 0; bj < 2; ++bj)
#pragma unroll
                    for (int n = 0; n < 2; ++n) { const f32x4 v = acc[ai][bj][m][n]; s += (v[0] * v[0] + v[1] * v[1]) + (v[2] * v[2] + v[3] * v[3]); }
                s += __shfl_xor(s, 16); s += __shfl_xor(s, 32);
                if (fq == 0) (void)__hip_atomic_fetch_add(SS + row0 + ai * HALF + m * 16, s, __ATOMIC_RELAXED, __HIP_MEMORY_SCOPE_AGENT); }
        if (!second) {
#pragma unroll
            for (int ai = 0; ai < 2; ++ai)
#pragma unroll
                for (int m = 0; m < 4; ++m) { bf16_t* rowp = FB + (size_t)(row0 + ai * HALF + m * 16) * ldc + col0;
#pragma unroll
                    for (int bj = 0; bj < 2; ++bj) { const f32x4 v0 = acc[ai][bj][m][0], v1 = acc[ai][bj][m][1];
                        u32x4 w; w.x = cvt_pk_bf16(v0[0], v0[1]); w.y = cvt_pk_bf16(v0[2], v0[3]); w.z = cvt_pk_bf16(v1[0], v1[1]); w.w = cvt_pk_bf16(v1[2], v1[3]);
                        *(u32x4*)(rowp + bj * HALF) = w; } }
            return;
        }
        asm volatile("s_waitcnt vmcnt(0)" ::: "memory");
        __builtin_amdgcn_s_barrier();
        if (threadIdx.x == 0) {
            __builtin_amdgcn_fence(__ATOMIC_RELEASE, "agent");
            (void)__hip_atomic_fetch_add(CNT + 64 * u.pm, 1u, __ATOMIC_RELAXED, __HIP_MEMORY_SCOPE_AGENT);
            unsigned sp = 0;
            while (__hip_atomic_load(CNT + 64 * u.pm, __ATOMIC_RELAXED, __HIP_MEMORY_SCOPE_AGENT) < 4u) { __builtin_amdgcn_s_sleep(2); if (++sp > (1u << 22)) break; }
            __builtin_amdgcn_fence(__ATOMIC_ACQUIRE, "agent");
        }
        __builtin_amdgcn_s_barrier();
        asm volatile("" ::: "memory");
#pragma unroll
        for (int ai = 0; ai < 2; ++ai)
#pragma unroll
            for (int m = 0; m < 4; ++m) { const int row = row0 + ai * HALF + m * 16;
                const float r = 1.f / sqrtf(__hip_atomic_load(SS + row, __ATOMIC_RELAXED, __HIP_MEMORY_SCOPE_AGENT) * (1.f / 2048.f) + eps);
#pragma unroll
                for (int bj = 0; bj < 2; ++bj) {
                    const int col = col0 + bj * HALF; const size_t o = (size_t)row * ldc + col;
                    fin8(acc[ai][bj][m][0], acc[ai][bj][m][1], r, o, col);
                    const int colp = col - 4 * BM; const size_t op = (size_t)row * ldc + colp;
                    const u32x4 w = __builtin_nontemporal_load((const u32x4*)(FB + op));
                    const f32x4 p0 = {__builtin_bit_cast(float, w.x << 16), __builtin_bit_cast(float, w.x & 0xffff0000u), __builtin_bit_cast(float, w.y << 16), __builtin_bit_cast(float, w.y & 0xffff0000u)};
                    const f32x4 p1 = {__builtin_bit_cast(float, w.z << 16), __builtin_bit_cast(float, w.z & 0xffff0000u), __builtin_bit_cast(float, w.w << 16), __builtin_bit_cast(float, w.w & 0xffff0000u)};
                    fin8(p0, p1, r, op, colp); } }
    }
};

__device__ __forceinline__ float gelu_tanh(float x) {
    const float z = 0.7978845608028654f * (x + 0.044715f * x * x * x);
    const float e = __builtin_amdgcn_exp2f(-2.885390081777927f * z);
    return x * __builtin_amdgcn_rcpf(1.f + e);
}
#ifndef MK_DPP
#define MK_DPP 1
#endif
#if MK_DPP
__device__ __forceinline__ float ror1(float v) { return __builtin_bit_cast(float, __builtin_amdgcn_update_dpp(0, __builtin_bit_cast(int, v), 0x121, 0xf, 0xf, true)); }
__device__ __forceinline__ float rol1(float v) { return __builtin_bit_cast(float, __builtin_amdgcn_update_dpp(0, __builtin_bit_cast(int, v), 0x12f, 0xf, 0xf, true)); }
#else
__device__ __forceinline__ float ror1(float v) { const int l = threadIdx.x & 63; return __shfl(v, (l & 48) | ((l - 1) & 15)); }
__device__ __forceinline__ float rol1(float v) { const int l = threadIdx.x & 63; return __shfl(v, (l & 48) | ((l + 1) & 15)); }
#endif

struct EpiGeglu {
    static constexpr bool PERM = true, AFTER_DRAIN = false;
    bf16_t* ACT; const float* cw; const float* cb; f32x4* BB; int dff; const float* SS2; float eps;
    __device__ __forceinline__ void operator()(const f32x4 (&acc)[2][2][4][2], const Unit& u, int wr, int wc, int fr, int fq) const {
        const int gc0 = u.pn * 128 + wc * 32 + 8 * fq;
        f32x2 w0[4], w1[4], w2[4], bb[4];
        { const f32x4 a0 = *(const f32x4*)(cw + gc0), a1 = *(const f32x4*)(cw + gc0 + 4), b0 = *(const f32x4*)(cw + dff + gc0), b1 = *(const f32x4*)(cw + dff + gc0 + 4);
          const f32x4 c0 = *(const f32x4*)(cw + 2 * dff + gc0), c1 = *(const f32x4*)(cw + 2 * dff + gc0 + 4), d0 = *(const f32x4*)(cb + gc0), d1 = *(const f32x4*)(cb + gc0 + 4);
          w0[0] = (f32x2){a0.x, a0.y}; w0[1] = (f32x2){a0.z, a0.w}; w0[2] = (f32x2){a1.x, a1.y}; w0[3] = (f32x2){a1.z, a1.w};
          w1[0] = (f32x2){b0.x, b0.y}; w1[1] = (f32x2){b0.z, b0.w}; w1[2] = (f32x2){b1.x, b1.y}; w1[3] = (f32x2){b1.z, b1.w};
          w2[0] = (f32x2){c0.x, c0.y}; w2[1] = (f32x2){c0.z, c0.w}; w2[2] = (f32x2){c1.x, c1.y}; w2[3] = (f32x2){c1.z, c1.w};
          bb[0] = (f32x2){d0.x, d0.y}; bb[1] = (f32x2){d0.z, d0.w}; bb[2] = (f32x2){d1.x, d1.y}; bb[3] = (f32x2){d1.z, d1.w}; }
        const f32x2 K1 = (f32x2){-2.302208198f, -2.302208198f}, K2 = (f32x2){-0.102943239f, -0.102943239f}, ONE = (f32x2){1.f, 1.f}, ZERO = (f32x2){0.f, 0.f};
        const bool f0 = (fr == 0), f15 = (fr == 15);
#pragma unroll
        for (int ai = 0; ai < 2; ++ai) {
            const int chunk = u.pm * 4 + ai * 2 + wr; const int rbase = chunk * 64;
            f32x4* pF = BB + (size_t)(chunk * 2) * dff + gc0; f32x4* pL = pF + dff;
            unsigned pk[4][4];
            f32x2 rs[4];
#pragma unroll
            for (int m = 0; m < 4; ++m) { const float t = 1.f / sqrtf(SS2[rbase + m * 16 + fr] * (1.f / 2048.f) + eps); rs[m] = (f32x2){t, t}; }
#pragma unroll
            for (int jp = 0; jp < 4; ++jp) { const int n = jp >> 1, e0 = (jp & 1) * 2;
                f32x2 G[4], R[4], L[4];
#pragma unroll
                for (int m = 0; m < 4; ++m) { G[m] = (f32x2){acc[ai][0][m][n][e0], acc[ai][0][m][n][e0 + 1]} * rs[m];
                    R[m] = (f32x2){ror1(G[m].x), ror1(G[m].y)}; L[m] = (f32x2){rol1(G[m].x), rol1(G[m].y)}; }
#pragma unroll
                for (int m = 0; m < 4; ++m) {
                    const f32x2 uu = (f32x2){acc[ai][1][m][n][e0], acc[ai][1][m][n][e0 + 1]} * rs[m];
                    const f32x2 gup = f0 ? (m > 0 ? R[m > 0 ? m - 1 : 0] : ZERO) : R[m];
                    const f32x2 gdn = f15 ? (m < 3 ? L[m < 3 ? m + 1 : 3] : ZERO) : L[m];
                    const f32x2 pre = w0[jp] * gup + (w1[jp] * G[m] + (w2[jp] * gdn + bb[jp]));
                    const f32x2 a = pre * ((pre * pre) * K2 + K1);
                    f32x2 e; e.x = __builtin_amdgcn_exp2f(a.x); e.y = __builtin_amdgcn_exp2f(a.y);
                    const f32x2 d = e + ONE;
                    f32x2 r; r.x = __builtin_amdgcn_rcpf(d.x); r.y = __builtin_amdgcn_rcpf(d.y);
                    const f32x2 o = (pre * uu) * r;
                    pk[m][jp] = cvt_pk_bf16(o.x, o.y);
                    if (m == 0) { if (f0) { pF[2 * jp] = (f32x4){pre.x, G[m].x, uu.x, 0.f}; pF[2 * jp + 1] = (f32x4){pre.y, G[m].y, uu.y, 0.f}; } }
                    if (m == 3) { if (f15) { pL[2 * jp] = (f32x4){pre.x, G[m].x, uu.x, 0.f}; pL[2 * jp + 1] = (f32x4){pre.y, G[m].y, uu.y, 0.f}; } }
                }
            }
#pragma unroll
            for (int m = 0; m < 4; ++m) { u32x4 w; w.x = pk[m][0]; w.y = pk[m][1]; w.z = pk[m][2]; w.w = pk[m][3];
                __builtin_nontemporal_store(w, (u32x4*)(ACT + (size_t)(rbase + m * 16 + fr) * dff + gc0)); }
        }
    }
};

template <class Epi, class Sched, bool ALIGN_EPI = false, bool SP2 = false>
__device__ __forceinline__ void gemm_phase(PG8_LAS unsigned char* lds, const Gemm g, const Sched& S, const Epi& E) {
    const int tid = threadIdx.x, wid = __builtin_amdgcn_readfirstlane(tid >> 6), lane = tid & 63, wr = wid >> 2, wc = wid & 3, fr = lane & 15, fq = lane >> 4;
    const int K = g.K, nt = K / BK;
    unsigned voffA[2], voffB[2];
#pragma unroll
    for (int i = 0; i < 2; ++i) { int R, C; stage_rc(tid * 16 + i * 8192, R, C); const int Rb = Epi::PERM ? ((R & ~31) + perm32(R & 31)) : R;
        voffA[i] = (unsigned)(R * K + C) * 2u; voffB[i] = (unsigned)(Rb * K + C) * 2u; }
    const size_t kstep = (size_t)(BK * 2);
    const size_t hstep = (size_t)HALF * K * 2;
    const size_t tstep = 2 * hstep;
    const unsigned ldsw = (unsigned)wid * 1024u;
    const int aoff = lds_byte(wr * 64 + fr, fq * 8), boff = lds_byte(wc * 32 + fr, fq * 8);
#define PG8_SA(b, h) (((b) * 2 + (h)) * HTB)
#define PG8_SB(b, h) ((4 + (b) * 2 + (h)) * HTB)
#define PG8_STAGE(bufoff, gbase, voff) do { _Pragma("unroll") for (int _i = 0; _i < 2; ++_i) \
        __builtin_amdgcn_global_load_lds((const unsigned*)((const char*)(gbase) + (voff)[_i]), (PG8_LAS unsigned*)(lds + (bufoff) + ldsw + _i * 8192), 16, 0, 0); } while (0)
#define PG8_LDA(dst, b, h) do { _Pragma("unroll") for (int m = 0; m < 4; ++m) _Pragma("unroll") for (int k = 0; k < 2; ++k) dst[m][k] = *(const PG8_LAS bf16x8*)(lds + PG8_SA(b, h) + aoff + m * 2048 + k * 1024); } while (0)
#define PG8_LDB(dst, b, h) do { _Pragma("unroll") for (int n = 0; n < 2; ++n) _Pragma("unroll") for (int k = 0; k < 2; ++k) dst[n][k] = *(const PG8_LAS bf16x8*)(lds + PG8_SB(b, h) + boff + n * 2048 + k * 1024); } while (0)
#define PG8_MMA(ai, bj, At, Bt) do { __builtin_amdgcn_s_setprio(1); _Pragma("unroll") for (int m = 0; m < 4; ++m) _Pragma("unroll") for (int n = 0; n < 2; ++n) _Pragma("unroll") for (int k = 0; k < 2; ++k) \
        acc[ai][bj][m][n] = __builtin_amdgcn_mfma_f32_16x16x32_bf16(Bt[n][k], At[m][k], acc[ai][bj][m][n], 0, 0, 0); __builtin_amdgcn_s_setprio(0); } while (0)
#define PG8_WAIT_V(n) asm volatile("s_waitcnt vmcnt(" #n ")" ::: "memory")
#define PG8_WAIT_L(n) asm volatile("s_waitcnt lgkmcnt(" #n ")" ::: "memory")
#define PG8_BAR __builtin_amdgcn_s_barrier()
#define PG8_SCHED __builtin_amdgcn_sched_barrier(0)
    Unit cur, nxt; int ui = 0;
    if (!S.next(0, cur)) return;
    f32x4 acc[2][2][4][2];
#pragma unroll
    for (int a = 0; a < 2; ++a)
#pragma unroll
        for (int b = 0; b < 2; ++b)
#pragma unroll
            for (int m = 0; m < 4; ++m)
#pragma unroll
                for (int n = 0; n < 2; ++n) acc[a][b][m][n] = (f32x4){0.f, 0.f, 0.f, 0.f};
    bf16x8 At[4][2], B0[2][2], B1[2][2];
    const char* cA = (const char*)g.A + (size_t)cur.pm * tstep; const char* cB = (const char*)g.Bt + (size_t)cur.pn * tstep;
    S.a_ready(cur);
    if constexpr (SP2) {
        PG8_STAGE(PG8_SB(0, 0), cB, voffB); PG8_STAGE(PG8_SB(0, 1), cB + hstep, voffB); PG8_STAGE(PG8_SA(0, 0), cA, voffA); PG8_STAGE(PG8_SA(0, 1), cA + hstep, voffA);
        if (wr == 1) PG8_BAR;
        PG8_WAIT_V(2); PG8_BAR;
        PG8_STAGE(PG8_SB(1, 0), cB + kstep, voffB); PG8_STAGE(PG8_SA(1, 0), cA + kstep, voffA); PG8_STAGE(PG8_SB(1, 1), cB + hstep + kstep, voffB);
        PG8_WAIT_V(6); PG8_BAR;
    } else {
        PG8_STAGE(PG8_SB(0, 0), cB, voffB); PG8_STAGE(PG8_SA(0, 0), cA, voffA); PG8_STAGE(PG8_SB(0, 1), cB + hstep, voffB); PG8_STAGE(PG8_SA(0, 1), cA + hstep, voffA);
        if (wr == 1) PG8_BAR;
        PG8_WAIT_V(4); PG8_BAR;
        PG8_STAGE(PG8_SB(1, 0), cB + kstep, voffB); PG8_STAGE(PG8_SA(1, 0), cA + kstep, voffA); PG8_STAGE(PG8_SB(1, 1), cB + hstep + kstep, voffB);
        PG8_WAIT_V(6); PG8_BAR;
    }
    for (;;) {
        const bool has_next = S.next(ui + 1, nxt);
        const char* nA = has_next ? (const char*)g.A + (size_t)nxt.pm * tstep : cA; const char* nB = has_next ? (const char*)g.Bt + (size_t)nxt.pn * tstep : cB;
        for (int t = 0; t < nt; t += 2) {
            const bool last = (t == nt - 2);
            const char* a1 = cA + (size_t)(t + 1) * kstep;
            const char* a2 = last ? nA : cA + (size_t)(t + 2) * kstep; const char* b2 = last ? nB : cB + (size_t)(t + 2) * kstep;
            const char* a3 = a2 + kstep; const char* b3 = b2 + kstep;
            if (last && has_next) S.a_ready(nxt);
            if constexpr (SP2) {
            PG8_LDB(B0, 0, 0); PG8_LDB(B1, 0, 1); PG8_SCHED; PG8_LDA(At, 0, 0); PG8_STAGE(PG8_SA(1, 1), a1 + hstep, voffA);
            PG8_WAIT_V(8); PG8_WAIT_L(0); PG8_BAR; PG8_MMA(0, 0, At, B0); PG8_MMA(0, 1, At, B1); PG8_BAR; PG8_SCHED;
            PG8_LDA(At, 0, 1); PG8_STAGE(PG8_SB(0, 0), b2, voffB); PG8_STAGE(PG8_SB(0, 1), b2 + hstep, voffB); PG8_STAGE(PG8_SA(0, 0), a2, voffA);
            PG8_WAIT_V(8); PG8_WAIT_L(0); PG8_BAR; PG8_MMA(1, 0, At, B0); PG8_MMA(1, 1, At, B1); PG8_BAR; PG8_SCHED;
            PG8_LDB(B0, 1, 0); PG8_LDB(B1, 1, 1); PG8_SCHED; PG8_LDA(At, 1, 0); PG8_STAGE(PG8_SA(0, 1), a2 + hstep, voffA);
            PG8_WAIT_V(8); PG8_WAIT_L(0); PG8_BAR; PG8_MMA(0, 0, At, B0); PG8_MMA(0, 1, At, B1); PG8_BAR; PG8_SCHED;
            PG8_LDA(At, 1, 1); PG8_STAGE(PG8_SB(1, 0), b3, voffB); PG8_STAGE(PG8_SB(1, 1), b3 + hstep, voffB); PG8_STAGE(PG8_SA(1, 0), a3, voffA);
            PG8_WAIT_V(8); PG8_WAIT_L(0); PG8_BAR; PG8_MMA(1, 0, At, B0); PG8_MMA(1, 1, At, B1); PG8_BAR; PG8_SCHED;
            } else {
            PG8_LDB(B0, 0, 0); PG8_SCHED; PG8_LDA(At, 0, 0); PG8_STAGE(PG8_SA(1, 1), a1 + hstep, voffA);
            PG8_WAIT_L(8); PG8_BAR; PG8_WAIT_L(0); PG8_MMA(0, 0, At, B0); PG8_BAR; PG8_SCHED;
            PG8_LDB(B1, 0, 1); PG8_STAGE(PG8_SB(0, 0), b2, voffB);
            PG8_BAR; PG8_WAIT_L(0); PG8_MMA(0, 1, At, B1); PG8_BAR;
            PG8_LDA(At, 0, 1); PG8_STAGE(PG8_SA(0, 0), a2, voffA);
            PG8_BAR; PG8_WAIT_L(0); PG8_MMA(1, 0, At, B0); PG8_BAR; PG8_SCHED;
            PG8_STAGE(PG8_SB(0, 1), b2 + hstep, voffB);
            PG8_WAIT_V(6); PG8_BAR; PG8_MMA(1, 1, At, B1); PG8_BAR;
            PG8_LDB(B0, 1, 0); PG8_SCHED; PG8_LDA(At, 1, 0); PG8_STAGE(PG8_SA(0, 1), a2 + hstep, voffA);
            PG8_WAIT_L(8); PG8_BAR; PG8_WAIT_L(0); PG8_MMA(0, 0, At, B0); PG8_BAR; PG8_SCHED;
            PG8_LDB(B1, 1, 1); PG8_STAGE(PG8_SB(1, 0), b3, voffB);
            PG8_BAR; PG8_WAIT_L(0); PG8_MMA(0, 1, At, B1); PG8_BAR;
            PG8_LDA(At, 1, 1); PG8_STAGE(PG8_SA(1, 0), a3, voffA);
            PG8_BAR; PG8_WAIT_L(0); PG8_MMA(1, 0, At, B0); PG8_BAR; PG8_SCHED;
            PG8_STAGE(PG8_SB(1, 1), b3 + hstep, voffB);
            PG8_WAIT_V(6); PG8_BAR; PG8_MMA(1, 1, At, B1); PG8_BAR;
            }
        }
        if constexpr (ALIGN_EPI) { if (wr == 0) PG8_BAR; }
        if constexpr (!Epi::AFTER_DRAIN) { E(acc, cur, wr, wc, fr, fq); S.done(cur); }
        if (!has_next) break;
#pragma unroll
        for (int a = 0; a < 2; ++a)
#pragma unroll
            for (int b = 0; b < 2; ++b)
#pragma unroll
                for (int m = 0; m < 4; ++m)
#pragma unroll
                    for (int n = 0; n < 2; ++n) acc[a][b][m][n] = (f32x4){0.f, 0.f, 0.f, 0.f};
        cur = nxt; cA = nA; cB = nB; ++ui;
        if constexpr (ALIGN_EPI) { if (wr == 1) PG8_BAR; }
    }
    PG8_WAIT_V(0);
    if constexpr (!ALIGN_EPI) { if (wr == 0) PG8_BAR; }
    PG8_BAR;
    if constexpr (Epi::AFTER_DRAIN) { E.fused(acc, cur, wr, wc, fr, fq, lds, wid, lane); S.done(cur); }
#undef PG8_SA
#undef PG8_SB
#undef PG8_STAGE
#undef PG8_LDA
#undef PG8_LDB
#undef PG8_MMA
#undef PG8_WAIT_V
#undef PG8_WAIT_L
#undef PG8_BAR
#undef PG8_SCHED
}
}

#define GAS __attribute__((address_space(1)))
#define LAS __attribute__((address_space(3)))
typedef unsigned short bf16;
typedef unsigned v4u __attribute__((ext_vector_type(4)));
typedef unsigned v2u __attribute__((ext_vector_type(2)));
typedef float f32x4 __attribute__((ext_vector_type(4)));
typedef float f32x2 __attribute__((ext_vector_type(2)));
typedef float f32x16 __attribute__((ext_vector_type(16)));
typedef short bf16x8 __attribute__((ext_vector_type(8)));
typedef short s16x4 __attribute__((ext_vector_type(4)));

#ifndef MK_N_LAUNCHES
#define MK_N_LAUNCHES 1
#endif
constexpr int NPHASE = 13;
constexpr int NWAVES = 8, NTHR = 512;

constexpr int BATCH = 8, SEQ = 2048, DM = 2048, M = BATCH * SEQ;
constexpr int HW = 1024, NH = 8, DQK = 192, DNOPE = 128, DROPE = 64, DV = 128, QLR = 512, KVLR = 256;
constexpr int INW = 3 * HW + QLR + KVLR + DROPE, INWP = 4096;
constexpr int DFF = 5632, FE = 33, FH = 64;
constexpr int NQ = NH * DQK  , NKV = NH * (DNOPE + DV)  , AW = NH * DV  ;
constexpr float EPS = 1e-6f;
constexpr int KFLEN = 4112;

constexpr size_t MiB = 1u << 20;
constexpr size_t WS_CNT = 16384, WS_CNT2 = 32768, WS_SS1 = 65536, WS_SS2 = 131072, WS_SS3 = 196608, CTL_BYTES = 262144;
constexpr size_t WS_WIN = 1 * MiB, WS_WUQ = 17 * MiB, WS_WUKV = 19 * MiB, WS_WOUT = 20 * MiB, WS_WUP = 28 * MiB, WS_WDOWN = 72 * MiB;
constexpr size_t WS_H2 = 95 * MiB;
constexpr size_t WS_ROPE = 94 * MiB;
constexpr size_t WS_XN = 96 * MiB;
constexpr size_t WS_UT = 96 * MiB, WS_X0T = 128 * MiB;
constexpr size_t WS_PROJ = 160 * MiB;
constexpr size_t WS_MIXIN = 160 * MiB, WS_O = 224 * MiB, WS_MIXED = 256 * MiB;
constexpr size_t WS_CQN = 320 * MiB, WS_CKVN = 336 * MiB, WS_KPE = 344 * MiB, WS_KF = 346 * MiB;
constexpr size_t WS_Q = 356 * MiB, WS_KV = 404 * MiB;
constexpr size_t WS_YT = 468 * MiB;
constexpr size_t WS_ACT = 160 * MiB;
constexpr size_t WS_BB = 336 * MiB;
constexpr size_t WS_F = 96 * MiB;
constexpr size_t WS_H16 = 436 * MiB;
constexpr size_t WS_END = 500 * MiB;

constexpr int LDS_BYTES = 147456;

__device__ __forceinline__ unsigned f2bf(float f) { unsigned u = __builtin_bit_cast(unsigned, f); return (u + 0x7fffu + ((u >> 16) & 1u)) >> 16; }
__device__ __forceinline__ unsigned pk2(float lo, float hi) { return f2bf(lo) | (f2bf(hi) << 16); }
__device__ __forceinline__ float bflo(unsigned w) { return __builtin_bit_cast(float, w << 16); }
__device__ __forceinline__ float bfhi(unsigned w) { return __builtin_bit_cast(float, w & 0xffff0000u); }
__device__ __forceinline__ float bf1(bf16 h) { return __builtin_bit_cast(float, (unsigned)h << 16); }
#define LDS_WAIT() asm volatile("s_waitcnt lgkmcnt(0)" ::: "memory")
__device__ __forceinline__ float wave_sum(float v) {
#pragma unroll
    for (int o = 1; o < 64; o <<= 1) v += __shfl_xor(v, o);
    return v;
}
__device__ __forceinline__ void sincos_acc(float x, float& s, float& c) {
    const double xd = (double)x; const double k = rint(xd * 0.6366197723675814);
    const float y = (float)(xd - k * 1.5707963267948966); const int q = ((int)k) & 3;
    const float y2 = y * y;
    const float sp = y + y * y2 * (-1.6666654611e-1f + y2 * (8.3321608736e-3f + y2 * (-1.9515295891e-4f)));
    const float cp = 1.f - 0.5f * y2 + y2 * y2 * (4.166664568298827e-2f + y2 * (-1.388731625493765e-3f + y2 * 2.443315711809948e-5f));
    const float s0 = (q & 1) ? cp : sp, c0 = (q & 1) ? sp : cp;
    s = (q & 2) ? -s0 : s0; c = ((q + 1) & 2) ? -c0 : c0;
}

#define XB_TMO      128
#define XB_XCNT(j)  (256  + 64 * (j))
#define XB_XSUB(j)  (1280 + 64 * (j))
#define XB_XGEN(j)  (2304 + 64 * (j))
#define XB_TOP      3328
#define XB_TOPGEN   3392
#define XCD_BAR_WORDS 3456
#define XB_SPIN_CAP (1u << 18)

__device__ __forceinline__ unsigned xb_ld(unsigned* p)              { return __hip_atomic_load(p, __ATOMIC_RELAXED, __HIP_MEMORY_SCOPE_AGENT); }
__device__ __forceinline__ unsigned xb_add(unsigned* p, unsigned v) { return __hip_atomic_fetch_add(p, v, __ATOMIC_RELAXED, __HIP_MEMORY_SCOPE_AGENT); }
__device__ __forceinline__ unsigned xb_xcc_id() { return (unsigned)__builtin_amdgcn_s_getreg((3 << 11) | 20) & 0xFu; }
#define XB_SPIN(cond, bar) do { unsigned _sp = 0; while (cond) { __builtin_amdgcn_s_sleep(1); \
    if ((++_sp & 255u) == 0u) { if (xb_ld(&(bar)[XB_TMO])) break; if (_sp > XB_SPIN_CAP) { atomicAdd(&(bar)[XB_TMO], 1u); break; } } } } while (0)

struct XcdBarrier {
    unsigned* bar; unsigned x;
    volatile LAS unsigned* st;
};

__device__ __forceinline__ XcdBarrier xcd_barrier_post(unsigned* bar, volatile LAS unsigned* st) {
    XcdBarrier b; b.bar = bar; b.x = xb_xcc_id(); b.st = st;
    if (threadIdx.x == 0) (void)xb_add(&bar[XB_XCNT(b.x)], 1u);
    return b;
}
__device__ __forceinline__ void xcd_barrier_complete(unsigned* bar, unsigned x, unsigned& nloc, unsigned& nx) {
    const unsigned G = gridDim.x * gridDim.y * gridDim.z;
    unsigned sum, cnt, mine, sp = 0u;
    for (;;) {
        sum = 0u; cnt = 0u; mine = 0u;
#pragma unroll
        for (unsigned j = 0; j < 16; ++j) { const unsigned c = xb_ld(&bar[XB_XCNT(j)]); sum += c; cnt += (c > 0u) ? 1u : 0u; mine = (j == x) ? c : mine; }
        if (sum == G) break;
        __builtin_amdgcn_s_sleep(1);
        if ((++sp & 255u) == 0u) { if (xb_ld(&bar[XB_TMO])) break; if (sp > XB_SPIN_CAP) { atomicAdd(&bar[XB_TMO], 1u); break; } }
    }
    nloc = mine > 0u ? mine : 1u; nx = cnt > 0u ? cnt : 1u;
}

__device__ __forceinline__ void xcd_barrier(const XcdBarrier& b) {
    asm volatile("s_waitcnt vmcnt(0)" ::: "memory");
    __syncthreads();
    if (threadIdx.x == 0) {
        unsigned* bar = b.bar;
        __builtin_amdgcn_s_waitcnt(0);
        unsigned nloc = b.st[0], nx = b.st[1];
        if (nloc == 0u) { xcd_barrier_complete(bar, b.x, nloc, nx); b.st[0] = nloc; b.st[1] = nx; }
        const unsigned old = xb_add(&bar[XB_XSUB(b.x)], 1u);
        const unsigned gen = old / nloc;
        if (old + 1u == (gen + 1u) * nloc) {
            __builtin_amdgcn_fence(__ATOMIC_RELEASE, "agent");
            asm volatile("s_waitcnt vmcnt(0)" ::: "memory");
            const unsigned og = xb_add(&bar[XB_TOP], 1u);
            const unsigned tg = og / nx;
            if (og + 1u == (tg + 1u) * nx) xb_add(&bar[XB_TOPGEN], 1u);
            else XB_SPIN(xb_ld(&bar[XB_TOPGEN]) == tg, bar);
            __builtin_amdgcn_fence(__ATOMIC_ACQUIRE, "agent");
            xb_add(&bar[XB_XGEN(b.x)], 1u);
            asm volatile("s_waitcnt vmcnt(0)" ::: "memory");
        } else {
            XB_SPIN(xb_ld(&bar[XB_XGEN(b.x)]) == gen, bar);
            __builtin_amdgcn_fence(__ATOMIC_ACQUIRE, "agent");
            asm volatile("s_waitcnt vmcnt(0)" ::: "memory");
        }
    }
    __syncthreads();
}

struct Frame {
    LAS unsigned char* lds; char* ldsg;
    int tid, lane, wave, vcu, G;
    const float* in[27]; float* out; unsigned char* ws;
};

__device__ __forceinline__ void p0_transpose_item(const float* W, int K, int N, bf16* WT, int k0, int n0, int drow0, LAS float* scr, int lane, const float* kscale) {
    f32x4 v[8];
#pragma unroll
    for (int i = 0; i < 8; ++i) v[i] = __builtin_nontemporal_load((const f32x4*)(W + (size_t)(k0 + (lane >> 3) + 8 * i) * N + n0 + (lane & 7) * 4));
#pragma unroll
    for (int i = 0; i < 8; ++i) { LAS float* d = scr + ((lane >> 3) + 8 * i) * 33 + (lane & 7) * 4; d[0] = v[i].x; d[1] = v[i].y; d[2] = v[i].z; d[3] = v[i].w; }
    LDS_WAIT(); asm volatile("" ::: "memory");
    const int c = lane & 7;
    float ks[8];
#pragma unroll
    for (int e = 0; e < 8; ++e) ks[e] = kscale ? kscale[k0 + 8 * c + e] : 1.f;
#pragma unroll
    for (int j = 0; j < 4; ++j) { const int n = (lane >> 3) + 8 * j; const LAS float* s = scr + (8 * c) * 33 + n;
        v4u o; o.x = pk2(s[0 * 33] * ks[0], s[1 * 33] * ks[1]); o.y = pk2(s[2 * 33] * ks[2], s[3 * 33] * ks[3]); o.z = pk2(s[4 * 33] * ks[4], s[5 * 33] * ks[5]); o.w = pk2(s[6 * 33] * ks[6], s[7 * 33] * ks[7]);
        if (kscale || K == DFF || N == DM) __builtin_nontemporal_store(o, (v4u*)(WT + (size_t)(drow0 + n) * K + k0 + 8 * c));
        else *(GAS v4u*)(WT + (size_t)(drow0 + n) * K + k0 + 8 * c) = o; }
    LDS_WAIT(); asm volatile("" ::: "memory");
}
__device__ __forceinline__ void p0_transpose_mat(Frame& F, const float* W, int K, int N, bf16* WT, bool upmap, const float* kscale = nullptr) {
    LAS float* scr = (LAS float*)(F.lds + F.wave * 16384);
    const int gw = F.vcu * NWAVES + F.wave, NGW = F.G * NWAVES; const int nblk = N / 32, nitems = (K / 64) * nblk;
    for (int it = gw; it < nitems; it += NGW) { const int kb = it / nblk, nb = it % nblk, n0 = 32 * nb;
        int drow0 = n0;
        if (upmap) drow0 = (n0 < DFF) ? (n0 >> 7) * 256 + (n0 & 127) : ((n0 - DFF) >> 7) * 256 + 128 + ((n0 - DFF) & 127);
        p0_transpose_item(W, K, N, WT, 64 * kb, n0, drow0, scr, F.lane, kscale); }
}
__device__ __forceinline__ void rms_row_to_bf16(const float* xrow, const float* gain, bf16* orow, int lane) {
    f32x4 v[8]; float s = 0.f;
#pragma unroll
    for (int j = 0; j < 8; ++j) { v[j] = __builtin_nontemporal_load((const f32x4*)(xrow + 4 * (lane + 64 * j))); s += (v[j].x * v[j].x + v[j].y * v[j].y) + (v[j].z * v[j].z + v[j].w * v[j].w); }
    const float r = 1.f / sqrtf(wave_sum(s) * (1.f / DM) + EPS);
#pragma unroll
    for (int j = 0; j < 8; ++j) { const f32x4 g = *(const f32x4*)(gain + 4 * (lane + 64 * j));
        v2u o; o.x = pk2(v[j].x * r * g.x, v[j].y * r * g.y); o.y = pk2(v[j].z * r * g.z, v[j].w * r * g.w);
        *(v2u*)(orow + 4 * (lane + 64 * j)) = o; }
}
__device__ __forceinline__ void p0_filter_hidden(Frame& F) {
    LAS float* Z = (LAS float*)F.lds;
    LAS float* H1 = Z + 8 * 33;
    const float *w1 = F.in[5], *b1 = F.in[6], *fr1 = F.in[7], *w2 = F.in[8], *b2 = F.in[9], *fr2 = F.in[10];
    float* H2G = (float*)(F.ws + WS_H2);
    const int tid = F.tid;
    for (int unit = F.vcu; unit < SEQ / 8; unit += F.G) {
        const int l0 = unit * 8;
        __syncthreads();
        if (tid < 8 * 33) { const int l = l0 + tid / 33, f = tid % 33; float v;
            if (f == 0) v = (float)l * (1.0f / (float)(SEQ - 1));
            else { const int j = (f - 1) & 15; const float w = 6.283185307179586f * (float)l / (float)SEQ; const float fj = 1e-4f + (float)j * ((15.0f - 1e-4f) / 15.0f);
                float s, c; sincos_acc(w * fj, s, c); v = (f <= 16) ? c : -s; }
            Z[tid] = v; }
        __syncthreads();
        const int l = tid >> 6, k = tid & 63;
        { float a = b1[k];
#pragma unroll
          for (int f = 0; f < FE; ++f) a += Z[l * 33 + f] * w1[f * FH + k];
          float s, c; sincos_acc(fr1[k] * a, s, c); H1[l * 65 + k] = s; }
        __syncthreads();
        { float a = b2[k];
#pragma unroll 16
          for (int j = 0; j < FH; ++j) a += H1[l * 65 + j] * w2[j * FH + k];
          float s, c; sincos_acc(fr2[k] * a, s, c); H2G[(size_t)(l0 + l) * FH + k] = s; }
    }
    __syncthreads();
}
__device__ __forceinline__ void p2_filter_out(Frame& F) {
    LAS float* H2 = (LAS float*)F.lds;
    LAS float* W3 = H2 + 64 * 65 + 12;
    const float* w3 = F.in[11]; const float* H2G = (const float*)(F.ws + WS_H2);
    bf16* KF = (bf16*)(F.ws + WS_KF);
    const int tid = F.tid;
    for (int i = F.vcu * NTHR + tid; i < HW * 17; i += F.G * NTHR) KF[(size_t)(i / 17) * KFLEN + (i % 17)] = 0;
    for (int unit = F.vcu; unit < 32 * 16; unit += F.G) {
        const int l0 = (unit >> 4) * 64, n0 = (unit & 15) * 128;
        __syncthreads();
#pragma unroll
        for (int i = 0; i < 2; ++i) { const int id = tid + NTHR * i; const int l = id >> 4, k4 = (id & 15) * 4; const f32x4 v = *(const f32x4*)(H2G + (size_t)(l0 + l) * FH + k4);
            LAS float* d = H2 + l * 65 + k4; d[0] = v.x; d[1] = v.y; d[2] = v.z; d[3] = v.w; }
#pragma unroll
        for (int i = 0; i < 4; ++i) { const int id = tid + NTHR * i; const int k = id >> 5, c4 = (id & 31) * 4;
            *(LAS f32x4*)(W3 + k * 128 + c4) = *(const f32x4*)(w3 + (size_t)k * (2 * HW) + n0 + c4); }
        __syncthreads();
        { const int l = tid & 63, ng = __builtin_amdgcn_readfirstlane(tid >> 6); const int nb = n0 + ng * 16;
          float acc[16];
#pragma unroll
          for (int i = 0; i < 16; ++i) acc[i] = 0.f;
#pragma unroll 4
          for (int k = 0; k < FH; ++k) { const float h = H2[l * 65 + k]; const LAS f32x4* wr = (const LAS f32x4*)(W3 + k * 128 + ng * 16);
#pragma unroll
              for (int q = 0; q < 4; ++q) { const f32x4 wv = wr[q]; acc[4 * q] += h * wv.x; acc[4 * q + 1] += h * wv.y; acc[4 * q + 2] += h * wv.z; acc[4 * q + 3] += h * wv.w; } }
          const int lg = l0 + l; const float tl = (float)lg * (1.0f / (float)(SEQ - 1));
          const float mind = -3.0701134573253945f, maxd = -15.350567286626973f;
#pragma unroll
          for (int i = 0; i < 16; ++i) { const int n = nb + i, dir = n >> 10, c = n & 1023;
              const float delta = fabsf(mind + (float)c * ((maxd - mind) / 1023.0f));
              const float win = __expf(-tl * delta) + 0.05f; const float v = acc[i] * win;
              if (dir == 0) KF[(size_t)c * KFLEN + 16 + 2048 - lg] = (bf16)f2bf(v);
              else if (lg > 0) KF[(size_t)c * KFLEN + 16 + 2048 + lg] = (bf16)f2bf(v); }
        }
    }
    __syncthreads();
}
__device__ __forceinline__ void p0_prologue(Frame& F) {
    unsigned char* ws = F.ws;
    p0_transpose_mat(F, F.in[2], DM, INW, (bf16*)(ws + WS_WIN), false);
    p0_transpose_mat(F, F.in[14], QLR, NQ, (bf16*)(ws + WS_WUQ), false);
    p0_transpose_mat(F, F.in[16], KVLR, NKV, (bf16*)(ws + WS_WUKV), false);
    p0_transpose_mat(F, F.in[19], DM, DM, (bf16*)(ws + WS_WOUT), false);
    p0_transpose_mat(F, F.in[22], DM, 2 * DFF, (bf16*)(ws + WS_WUP), true, F.in[21]);
    p0_transpose_mat(F, F.in[25], DFF, DM, (bf16*)(ws + WS_WDOWN), false);
    const int gw = F.vcu * NWAVES + F.wave, NGW = F.G * NWAVES;
    bf16* XN = (bf16*)(ws + WS_XN);
    for (int m = gw; m < M; m += NGW) rms_row_to_bf16(F.in[0] + (size_t)m * DM, F.in[1], XN + (size_t)m * DM, F.lane);
}
__device__ __forceinline__ void p0_pre(Frame& F) {
    f32x2* ROPE = (f32x2*)(F.ws + WS_ROPE);
    for (int i = F.vcu * NTHR + F.tid; i < SEQ * 32; i += F.G * NTHR) { const int s = i >> 5, j = i & 31;
        const float invf = 1.0f / powf(10000.0f, (float)(2 * j) / 64.0f); const float ang = (float)s * invf;
        float sn, cs; sincos_acc(ang, sn, cs); ROPE[i] = (f32x2){cs, sn}; }
    p0_filter_hidden(F);
}

__device__ __forceinline__ void p2_hyena_prep(Frame& F) {
    constexpr int TP = 72;
    LAS bf16* TB = (LAS bf16*)F.lds;
    const bf16* PROJ = (const bf16*)(F.ws + WS_PROJ); bf16* UT = (bf16*)(F.ws + WS_UT); bf16* X0T = (bf16*)(F.ws + WS_X0T);
    const float* cw = F.in[3]; const float* cb = F.in[4];
    const int tid = F.tid, ch = tid & 7, sl = tid >> 3;
    int it = 0;
    for (int unit = F.vcu; unit < BATCH * 32 * 16; unit += F.G, ++it) {
        const int ct = unit & 15, st = (unit >> 4) & 31, b = unit >> 9; const int c0 = ct * 64 + ch * 8, s = st * 64 + sl;
        v4u w[3][3];
#pragma unroll
        for (int a = 0; a < 3; ++a)
#pragma unroll
            for (int j = 0; j < 3; ++j) { const int ss = s - 1 + j; w[a][j] = (v4u){0u, 0u, 0u, 0u};
                if (ss >= 0 && ss < SEQ) w[a][j] = *(const v4u*)(PROJ + (size_t)(b * SEQ + ss) * INWP + a * HW + c0); }
        float val[3][8];
#pragma unroll
        for (int a = 0; a < 3; ++a) { const float* wp = cw + a * HW + c0;
            const f32x4 k0a = *(const f32x4*)(wp), k0b = *(const f32x4*)(wp + 4), k1a = *(const f32x4*)(wp + 3 * HW), k1b = *(const f32x4*)(wp + 3 * HW + 4);
            const f32x4 k2a = *(const f32x4*)(wp + 6 * HW), k2b = *(const f32x4*)(wp + 6 * HW + 4), bba = *(const f32x4*)(cb + a * HW + c0), bbb = *(const f32x4*)(cb + a * HW + c0 + 4);
            const float k0[8] = {k0a.x, k0a.y, k0a.z, k0a.w, k0b.x, k0b.y, k0b.z, k0b.w}, k1[8] = {k1a.x, k1a.y, k1a.z, k1a.w, k1b.x, k1b.y, k1b.z, k1b.w};
            const float k2[8] = {k2a.x, k2a.y, k2a.z, k2a.w, k2b.x, k2b.y, k2b.z, k2b.w}, bb[8] = {bba.x, bba.y, bba.z, bba.w, bbb.x, bbb.y, bbb.z, bbb.w};
            const unsigned r0[4] = {w[a][0].x, w[a][0].y, w[a][0].z, w[a][0].w}, r1[4] = {w[a][1].x, w[a][1].y, w[a][1].z, w[a][1].w}, r2[4] = {w[a][2].x, w[a][2].y, w[a][2].z, w[a][2].w};
#pragma unroll
            for (int k = 0; k < 4; ++k) {
                val[a][2 * k] = k0[2 * k] * bflo(r0[k]) + k1[2 * k] * bflo(r1[k]) + k2[2 * k] * bflo(r2[k]) + bb[2 * k];
                val[a][2 * k + 1] = k0[2 * k + 1] * bfhi(r0[k]) + k1[2 * k + 1] * bfhi(r1[k]) + k2[2 * k + 1] * bfhi(r2[k]) + bb[2 * k + 1]; } }
        LAS bf16* Tu = TB + (it & 1) * (2 * 64 * TP); LAS bf16* Tx = Tu + 64 * TP;
#pragma unroll
        for (int e = 0; e < 8; ++e) { Tu[(ch * 8 + e) * TP + sl] = (bf16)f2bf(val[1][e] * val[2][e]); Tx[(ch * 8 + e) * TP + sl] = (bf16)f2bf(val[0][e]); }
        __syncthreads();
        { const int c = tid >> 3, pc = tid & 7; const size_t o = ((size_t)(ct * 64 + c) * BATCH + b) * SEQ + st * 64 + pc * 8;
          __builtin_nontemporal_store(*(const LAS v4u*)(Tu + c * TP + pc * 8), (v4u*)(UT + o)); __builtin_nontemporal_store(*(const LAS v4u*)(Tx + c * TP + pc * 8), (v4u*)(X0T + o)); }
    }
    __syncthreads();
}
__device__ __forceinline__ void p2_mla_prep(Frame& F) {
    const bf16* PROJ = (const bf16*)(F.ws + WS_PROJ); bf16* CQN = (bf16*)(F.ws + WS_CQN); bf16* CKVN = (bf16*)(F.ws + WS_CKVN); bf16* KPE = (bf16*)(F.ws + WS_KPE);
    const f32x2* ROPE = (const f32x2*)(F.ws + WS_ROPE);
    const float* gq = F.in[13]; const float* gkv = F.in[15];
    const int gw = F.vcu * NWAVES + F.wave, NGW = F.G * NWAVES, lane = F.lane;
    const f32x4 gq0 = *(const f32x4*)(gq + 8 * lane), gq1 = *(const f32x4*)(gq + 8 * lane + 4), gk0 = *(const f32x4*)(gkv + 4 * lane);
    constexpr int UR = 2;
    for (int m0 = gw; m0 < M; m0 += NGW * UR) {
        v4u wq[UR]; v2u wk[UR]; bf16 xp[UR]; f32x2 cs[UR];
#pragma unroll
        for (int u = 0; u < UR; ++u) { const int m = m0 + u * NGW; const bf16* row = PROJ + (size_t)m * INWP;
            wq[u] = __builtin_nontemporal_load((const v4u*)(row + 3 * HW + 8 * lane)); wk[u] = __builtin_nontemporal_load((const v2u*)(row + 3 * HW + QLR + 4 * lane));
            xp[u] = row[3 * HW + QLR + KVLR + lane]; cs[u] = ROPE[(m & (SEQ - 1)) * 32 + (lane & 31)]; }
#pragma unroll
        for (int u = 0; u < UR; ++u) { const int m = m0 + u * NGW;
            { const v4u w = wq[u];
              float v[8] = {bflo(w.x), bfhi(w.x), bflo(w.y), bfhi(w.y), bflo(w.z), bfhi(w.z), bflo(w.w), bfhi(w.w)}; float s = 0.f;
#pragma unroll
              for (int i = 0; i < 8; ++i) s += v[i] * v[i];
              const float r = 1.f / sqrtf(wave_sum(s) * (1.f / QLR) + EPS);
              v4u o; o.x = pk2(v[0] * r * gq0.x, v[1] * r * gq0.y); o.y = pk2(v[2] * r * gq0.z, v[3] * r * gq0.w); o.z = pk2(v[4] * r * gq1.x, v[5] * r * gq1.y); o.w = pk2(v[6] * r * gq1.z, v[7] * r * gq1.w);
              *(v4u*)(CQN + (size_t)m * QLR + 8 * lane) = o; }
            { const v2u w = wk[u];
              float v[4] = {bflo(w.x), bfhi(w.x), bflo(w.y), bfhi(w.y)}; float s = (v[0] * v[0] + v[1] * v[1]) + (v[2] * v[2] + v[3] * v[3]);
              const float r = 1.f / sqrtf(wave_sum(s) * (1.f / KVLR) + EPS);
              v2u o; o.x = pk2(v[0] * r * gk0.x, v[1] * r * gk0.y); o.y = pk2(v[2] * r * gk0.z, v[3] * r * gk0.w);
              *(v2u*)(CKVN + (size_t)m * KVLR + 4 * lane) = o; }
            { const float x = bf1(xp[u]); const float p = __shfl_xor(x, 32);
              const float o = x * cs[u].x + ((lane < 32) ? -p : p) * cs[u].y;
              KPE[(size_t)m * DROPE + lane] = (bf16)f2bf(o); } }
    }
}

constexpr int US_PITCH = 2120;
constexpr int KFP = 4120;
__device__ __forceinline__ bf16x8 hy_afrag(const LAS bf16* FC, int a, int i, int quad) {
    const int sh = i & 7;
    return *(const LAS bf16x8*)(FC + sh * KFP + (16 + 2048 - 32 * a + quad * 8 - (i - sh)));
}
__device__ __forceinline__ void p4_longconv(Frame& F) {
    LAS bf16* FL = (LAS bf16*)F.lds;
    LAS bf16* US = (LAS bf16*)(F.lds + 66048);
    const bf16* KF = (const bf16*)(F.ws + WS_KF); const bf16* UT = (const bf16*)(F.ws + WS_UT); const bf16* X0T = (const bf16*)(F.ws + WS_X0T); bf16* YT = (bf16*)(F.ws + WS_YT);
    const float* hbias = F.in[12];
    const int tid = F.tid, lane = F.lane, w = F.wave, i16 = lane & 15, quad = lane >> 4, batch = lane & 7, g = (lane >> 3) & 1;
    for (int c = F.vcu; c < HW; c += F.G) {
        __syncthreads();
        { v4u kf[9], us[4];
#pragma unroll
          for (int i = 0; i < 9; ++i) { const int id = tid + NTHR * i; const int sh = id & 7, ck = (id >> 3) + 1;
              kf[i] = (v4u){0u, 0u, 0u, 0u}; if (id < 8 * 513) __builtin_memcpy(&kf[i], (const char*)(KF + (size_t)c * KFLEN + ck * 8 - sh), 16); }
#pragma unroll
          for (int i = 0; i < 4; ++i) { const int id = tid + NTHR * i; const int b = id >> 8, ch = id & 255;
              us[i] = __builtin_nontemporal_load((const v4u*)(UT + ((size_t)c * BATCH + b) * SEQ + ch * 8)); }
#pragma unroll
          for (int i = 0; i < 9; ++i) { const int id = tid + NTHR * i; const int sh = id & 7, ck = (id >> 3) + 1; if (id < 8 * 513) *(LAS v4u*)(FL + sh * KFP + ck * 8) = kf[i]; }
#pragma unroll
          for (int i = 0; i < 4; ++i) { const int id = tid + NTHR * i; const int b = id >> 8, ch = id & 255; *(LAS v4u*)(US + b * US_PITCH + 32 + ch * 8) = us[i]; } }
        for (int id = tid; id < 8 * 9; id += NTHR) { const int b = id / 9, ch = id % 9;
            const int off = (ch < 4) ? ch * 8 : 32 + 2048 + (ch - 4) * 8; *(LAS v4u*)(US + b * US_PITCH + off) = (v4u){0u, 0u, 0u, 0u}; }
        __syncthreads();
        f32x4 acc[8]; bf16x8 ar[8];
#pragma unroll
        for (int p = 0; p < 8; ++p) acc[p] = (f32x4){0.f, 0.f, 0.f, 0.f};
#pragma unroll
        for (int p = 0; p < 8; ++p) ar[p] = hy_afrag(FL, 8 * w + p + 1, i16, quad);
        const LAS bf16* ub = US + batch * US_PITCH + 32 + 16 * g + quad * 8;
        bf16x8 bcur = *(const LAS bf16x8*)(ub - 32);
        for (int J = 0; J < 9; ++J) {
#pragma unroll
            for (int jj8 = 0; jj8 < 8; ++jj8) {
                const int jj = J * 8 + jj8;
                if (jj < 65) {
                    const int j = jj - 1; const bool more = (jj + 1 < 65);
                    bf16x8 bnext = bcur, anext = ar[(7 - jj8) & 7];
                    if (more) { bnext = *(const LAS bf16x8*)(ub + 32 * (j + 1)); anext = hy_afrag(FL, 8 * w - (j + 1), i16, quad); }
#pragma unroll
                    for (int p = 0; p < 8; ++p) acc[p] = __builtin_amdgcn_mfma_f32_16x16x32_bf16(ar[(p - jj8) & 7], bcur, acc[p], 0, 0, 0);
                    ar[(7 - jj8) & 7] = anext; bcur = bnext;
                }
            }
        }
        const float hb = hbias[c];
#pragma unroll
        for (int p = 0; p < 8; ++p) { const int t = 32 * (8 * w + p) + 16 * g + quad * 4;
            const size_t o = ((size_t)c * BATCH + batch) * SEQ + t;
            const v2u xw = __builtin_nontemporal_load((const v2u*)(X0T + o)); const v2u uw = *(const LAS v2u*)(US + batch * US_PITCH + 32 + t);
            const float y0 = bflo(xw.x) * (acc[p][0] + hb * bflo(uw.x)), y1 = bfhi(xw.x) * (acc[p][1] + hb * bfhi(uw.x));
            const float y2 = bflo(xw.y) * (acc[p][2] + hb * bflo(uw.y)), y3 = bfhi(xw.y) * (acc[p][3] + hb * bfhi(uw.y));
            v2u ov; ov.x = pk2(y0, y1); ov.y = pk2(y2, y3); __builtin_nontemporal_store(ov, (v2u*)(YT + o)); }
    }
    __syncthreads();
}

namespace att {
constexpr int QBLK = 32, KVBLK = 64;
constexpr float SCALE = 0.07216878364870322f;
constexpr float THR = 8.f;
constexpr int SHM_V = KVBLK * DV * 2  , SHM_K = KVBLK * DQK * 2  , SHM_ATTN = 2 * SHM_V + 2 * SHM_K + NWAVES * 64 * 4;
#define KSWZ(row, colB) ((row) * 384 + ((colB) ^ ((((row) >> 1) & 7) << 4)))
#define SBAR() __builtin_amdgcn_sched_barrier(0)
__device__ __forceinline__ int crow(int r, int hi) { return (r & 3) + 8 * (r >> 2) + 4 * hi; }
__device__ __forceinline__ unsigned cvtpk(float lo, float hi) { unsigned r; asm volatile("v_cvt_pk_bf16_f32 %0, %1, %2" : "=v"(r) : "v"(lo), "v"(hi)); return r; }
__device__ __forceinline__ void partialSM(f32x16& p0, f32x16& p1, float& m_reg, float& mn, float& alpha) {
  constexpr float C = SCALE * 1.4426950408889634f;
  float pmax = p0[0];
#pragma unroll
  for (int r = 1; r < 16; ++r) pmax = fmaxf(pmax, p0[r]);
#pragma unroll
  for (int r = 0; r < 16; ++r) pmax = fmaxf(pmax, p1[r]);
  { auto rr = __builtin_amdgcn_permlane32_swap(__float_as_uint(pmax), __float_as_uint(pmax), false, false);
    pmax = fmaxf(__uint_as_float(rr[0]), __uint_as_float(rr[1])); }
  if (__builtin_expect(__all(pmax - m_reg <= THR / SCALE), 1)) { mn = m_reg; alpha = 1.f; }
  else { mn = fmaxf(m_reg, pmax); alpha = __builtin_amdgcn_exp2f((m_reg - mn) * C); m_reg = mn; }
  float mnC = -mn * C;
#pragma unroll
  for (int r = 0; r < 16; ++r) p0[r] = fmaf(p0[r], C, mnC);
#pragma unroll
  for (int r = 0; r < 16; ++r) p1[r] = fmaf(p1[r], C, mnC);
#pragma unroll
  for (int r = 0; r < 16; ++r) p0[r] = __builtin_amdgcn_exp2f(p0[r]);
}
__device__ __forceinline__ void finishSM(f32x16& p0, f32x16& p1, float alpha, float& l_reg, bf16x8& pa0, bf16x8& pa1, bf16x8& pa2, bf16x8& pa3) {
#pragma unroll
  for (int r = 0; r < 16; ++r) p1[r] = __builtin_amdgcn_exp2f(p1[r]);
  float ps = 0;
#pragma unroll
  for (int r = 0; r < 16; ++r) ps += p0[r];
#pragma unroll
  for (int r = 0; r < 16; ++r) ps += p1[r];
  { auto rr = __builtin_amdgcn_permlane32_swap(__float_as_uint(ps), __float_as_uint(ps), false, false);
    ps = __uint_as_float(rr[0]) + __uint_as_float(rr[1]); }
  l_reg = l_reg * alpha + ps;
#define PK4(P, BASE, OUT) do { unsigned a0 = cvtpk(P[BASE + 0], P[BASE + 1]), a1 = cvtpk(P[BASE + 2], P[BASE + 3]);   \
    unsigned b0 = cvtpk(P[BASE + 4], P[BASE + 5]), b1 = cvtpk(P[BASE + 6], P[BASE + 7]);                              \
    auto r0 = __builtin_amdgcn_permlane32_swap(a0, b0, false, false); auto r1 = __builtin_amdgcn_permlane32_swap(a1, b1, false, false); \
    v4u w = {r0[0], r1[0], r0[1], r1[1]}; OUT = __builtin_bit_cast(bf16x8, w); } while (0)
  PK4(p0, 0, pa0); PK4(p0, 8, pa1); PK4(p1, 0, pa2); PK4(p1, 8, pa3);
#undef PK4
}
__device__ __forceinline__ void qkt(f32x16& p0, f32x16& p1, const char* Ks, const bf16x8* qr, int r32, int hi) {
  p0 = f32x16{}; p1 = f32x16{};
#pragma unroll
  for (int d0 = 0; d0 < 12; ++d0) { int cb = (d0 * 16 + hi * 8) * 2;
    bf16x8 b0 = *reinterpret_cast<const bf16x8*>(Ks + KSWZ(r32, cb));
    bf16x8 b1 = *reinterpret_cast<const bf16x8*>(Ks + KSWZ(32 + r32, cb));
    p0 = __builtin_amdgcn_mfma_f32_32x32x16_bf16(b0, qr[d0], p0, 0, 0, 0);
    p1 = __builtin_amdgcn_mfma_f32_32x32x16_bf16(b1, qr[d0], p1, 0, 0, 0); }
}
__device__ __forceinline__ int v_st(int k, int c) { const int kk = (k & ~0xC) | ((k & 4) << 1) | ((k & 8) >> 1); return ((kk >> 3) * 4 + (c >> 5)) * 512 + ((kk & 7) * 32 + (c & 31)) * 2; }
__device__ __forceinline__ int v_rd_base(int lane) { return ((lane & 3) << 3) | (((lane >> 2) & 3) << 6) | (((lane >> 4) & 1) << 5) | (((lane >> 5) & 1) << 8); }
constexpr int v_rd_off(int d0, int ks, int half) { return d0 * 512 + ks * 4096 + half * 2048; }
template <int OFF> __device__ __forceinline__ s16x4 tr_read(int vb) {
  s16x4 r; asm volatile("ds_read_b64_tr_b16 %0, %1 offset:%2" : "=&v"(r) : "v"(vb), "i"(OFF) : "memory"); return r;
}
template <int D0> __device__ __forceinline__ void pv_one(f32x16& od, int vb, bf16x8 pa0, bf16x8 pa1, bf16x8 pa2, bf16x8 pa3) {
  const s16x4 l0 = tr_read<v_rd_off(D0, 0, 0)>(vb), h0 = tr_read<v_rd_off(D0, 0, 1)>(vb), l1 = tr_read<v_rd_off(D0, 1, 0)>(vb), h1 = tr_read<v_rd_off(D0, 1, 1)>(vb);
  const s16x4 l2 = tr_read<v_rd_off(D0, 2, 0)>(vb), h2 = tr_read<v_rd_off(D0, 2, 1)>(vb), l3 = tr_read<v_rd_off(D0, 3, 0)>(vb), h3 = tr_read<v_rd_off(D0, 3, 1)>(vb);
  asm volatile("s_waitcnt lgkmcnt(0)" ::: "memory"); SBAR();
#define PK(L, H) (bf16x8){L[0], L[1], L[2], L[3], H[0], H[1], H[2], H[3]}
  od = __builtin_amdgcn_mfma_f32_32x32x16_bf16(pa0, PK(l0, h0), od, 0, 0, 0);
  od = __builtin_amdgcn_mfma_f32_32x32x16_bf16(pa1, PK(l1, h1), od, 0, 0, 0);
  od = __builtin_amdgcn_mfma_f32_32x32x16_bf16(pa2, PK(l2, h2), od, 0, 0, 0);
  od = __builtin_amdgcn_mfma_f32_32x32x16_bf16(pa3, PK(l3, h3), od, 0, 0, 0);
#undef PK
}
__device__ __forceinline__ void pv_d0(f32x16* o, int vb, bf16x8 pa0, bf16x8 pa1, bf16x8 pa2, bf16x8 pa3) {
  pv_one<0>(o[0], vb, pa0, pa1, pa2, pa3); pv_one<1>(o[1], vb, pa0, pa1, pa2, pa3); pv_one<2>(o[2], vb, pa0, pa1, pa2, pa3); pv_one<3>(o[3], vb, pa0, pa1, pa2, pa3);
}
__device__ __forceinline__ void attn_unit(const bf16* __restrict__ Qb, const bf16* __restrict__ KVh, const bf16* __restrict__ KPb, bf16* __restrict__ Ob, const f32x2* __restrict__ rope, char* lds) {
  const int tid = threadIdx.x, wid = tid >> 6, lane = tid & 63, r32 = lane & 31, hi = lane >> 5;
  char* V_lds = lds; char* K_lds = lds + 2 * SHM_V;
  float* wsf = (float*)(lds + 2 * SHM_V + 2 * SHM_K) + wid * 64; float* li_l = wsf; float* al_l = wsf + 32;
  float m_reg = -1e30f, l_reg = 0; f32x16 o[4] = {}; bf16x8 qr[12];
  { const bf16* Qw = Qb + (size_t)(wid * QBLK + r32) * NQ + hi * 8;
#pragma unroll
    for (int d0 = 0; d0 < 8; ++d0) qr[d0] = *reinterpret_cast<const bf16x8*>(Qw + d0 * 16);
    const f32x2* rp = rope + (size_t)(wid * QBLK + r32) * 32 + hi * 8;
#pragma unroll
    for (int pp = 0; pp < 2; ++pp) {
      const v4u wa = *reinterpret_cast<const v4u*>(Qw + 128 + 16 * pp), wb = *reinterpret_cast<const v4u*>(Qw + 128 + 32 + 16 * pp);
      const unsigned a[4] = {wa.x, wa.y, wa.z, wa.w}, b[4] = {wb.x, wb.y, wb.z, wb.w}; unsigned oa[4], ob[4];
#pragma unroll
      for (int k = 0; k < 4; ++k) { const f32x2 cs0 = rp[16 * pp + 2 * k], cs1 = rp[16 * pp + 2 * k + 1];
        const float x0 = bflo(a[k]), x1 = bfhi(a[k]), y0 = bflo(b[k]), y1 = bfhi(b[k]);
        oa[k] = cvtpk(x0 * cs0.x - y0 * cs0.y, x1 * cs1.x - y1 * cs1.y);
        ob[k] = cvtpk(y0 * cs0.x + x0 * cs0.y, y1 * cs1.x + x1 * cs1.y); }
      qr[8 + pp] = __builtin_bit_cast(bf16x8, (v4u){oa[0], oa[1], oa[2], oa[3]}); qr[10 + pp] = __builtin_bit_cast(bf16x8, (v4u){ob[0], ob[1], ob[2], ob[3]}); }
  }
  const int sr = tid >> 4, sc = (tid & 15) * 8, vst0 = v_st(sr, sc), vst1 = v_st(32 + sr, sc);
  const int pr = tid >> 3, pc = (tid & 7) * 8;
  const int vb0 = (int)(uintptr_t)V_lds + v_rd_base(lane);
  const bf16* gkv = KVh + (size_t)sr * NKV + sc; const bf16* gkp = KPb + (size_t)pr * DROPE + pc;
  const int kst0 = KSWZ(sr, sc * 2), kst1 = KSWZ(32 + sr, sc * 2), kst2 = KSWZ(pr, 256 + pc * 2);
  bf16x8 vs0, vs1, ks0, ks1, ks2;
#define SLOAD(k0) do { const bf16* g_ = gkv + (size_t)(k0) * NKV; ks0 = *reinterpret_cast<const bf16x8*>(g_); vs0 = *reinterpret_cast<const bf16x8*>(g_ + 128); \
    ks1 = *reinterpret_cast<const bf16x8*>(g_ + 32 * NKV); vs1 = *reinterpret_cast<const bf16x8*>(g_ + 32 * NKV + 128); ks2 = *reinterpret_cast<const bf16x8*>(gkp + (size_t)(k0) * DROPE); } while (0)
#define SWRITE(b) do { *(bf16x8*)(V_lds + (b) * SHM_V + vst0) = vs0; *(bf16x8*)(V_lds + (b) * SHM_V + vst1) = vs1; \
    *(bf16x8*)(K_lds + (b) * SHM_K + kst0) = ks0; *(bf16x8*)(K_lds + (b) * SHM_K + kst1) = ks1; *(bf16x8*)(K_lds + (b) * SHM_K + kst2) = ks2; } while (0)
#define SWAIT() asm volatile("s_waitcnt vmcnt(0)" ::: "memory")
#define RESC(a) do { if (__any((a) < 1.f)) { if (hi == 0) al_l[r32] = (a); asm volatile("s_waitcnt lgkmcnt(0)" ::: "memory"); \
    _Pragma("unroll") for (int d = 0; d < 4; ++d) _Pragma("unroll") for (int r = 0; r < 16; ++r) o[d][r] *= al_l[crow(r, hi)]; } } while (0)
  f32x16 p0, p1; float mn, al; bf16x8 pa0, pa1, pa2, pa3; constexpr int NT = SEQ / KVBLK;
  SLOAD(0); SWAIT(); SWRITE(0); __syncthreads();
  for (int j = 0; j < NT; ++j) {
    const int bsel = j & 1;
    SBAR(); qkt(p0, p1, K_lds + bsel * SHM_K, qr, r32, hi); SBAR();
    if (j + 1 < NT) SLOAD((j + 1) * KVBLK);
    SBAR();
    partialSM(p0, p1, m_reg, mn, al); RESC(al);
    finishSM(p0, p1, al, l_reg, pa0, pa1, pa2, pa3); SBAR();
    pv_d0(o, vb0 + bsel * SHM_V, pa0, pa1, pa2, pa3);
    if (j + 1 < NT) { SWAIT(); SWRITE(bsel ^ 1); }
    __syncthreads();
  }
  if (hi == 0) li_l[r32] = l_reg; asm volatile("s_waitcnt lgkmcnt(0)" ::: "memory");
  float rli[16];
#pragma unroll
  for (int r = 0; r < 16; ++r) rli[r] = __builtin_amdgcn_rcpf(li_l[crow(r, hi)]);
  bf16* Ow = Ob + (size_t)(wid * QBLK) * AW;
#pragma unroll
  for (int r = 0; r < 16; ++r) { int orow = crow(r, hi);
#pragma unroll
    for (int d0 = 0; d0 < 4; ++d0) Ow[(size_t)orow * AW + d0 * 32 + r32] = (bf16)f2bf(o[d0][r] * rli[r]); }
  __syncthreads();
#undef SLOAD
#undef SWRITE
#undef SWAIT
#undef RESC
}
}

__device__ __forceinline__ void p5_attention(Frame& F) {
    const bf16* Q = (const bf16*)(F.ws + WS_Q); const bf16* KV = (const bf16*)(F.ws + WS_KV); const bf16* KPE = (const bf16*)(F.ws + WS_KPE); bf16* O = (bf16*)(F.ws + WS_O);
    const f32x2* ROPE = (const f32x2*)(F.ws + WS_ROPE);
    for (int unit = F.vcu; unit < BATCH * NH * 8; unit += F.G) {
        const int qb = unit & 7, bh = unit >> 3, b = bh >> 3, h = bh & 7; const size_t m0 = (size_t)b * SEQ + qb * 256;
        att::attn_unit(Q + m0 * NQ + h * DQK, KV + (size_t)b * SEQ * NKV + h * 256, KPE + (size_t)b * SEQ * DROPE, O + m0 * AW + h * DV, ROPE + qb * 256 * 32, F.ldsg);
    }
}

__device__ __forceinline__ void p6_mixnorm(Frame& F) {
    const bf16* O = (const bf16*)(F.ws + WS_O); const bf16* YT = (const bf16*)(F.ws + WS_YT); bf16* MIXIN = (bf16*)(F.ws + WS_MIXIN);
    const float* gh = F.in[17]; const float* ga = F.in[18];
    const int gw = F.vcu * NWAVES + F.wave, NGW = F.G * NWAVES, lane = F.lane, tid = F.tid;
    for (int m0 = gw; m0 < M; m0 += NGW * 2) {
        v4u w[2][2];
#pragma unroll
        for (int u = 0; u < 2; ++u)
#pragma unroll
            for (int j = 0; j < 2; ++j) w[u][j] = __builtin_nontemporal_load((const v4u*)(O + (size_t)(m0 + u * NGW) * AW + 8 * (lane + 64 * j)));
#pragma unroll
        for (int u = 0; u < 2; ++u) { const int m = m0 + u * NGW; float s = 0.f;
#pragma unroll
            for (int j = 0; j < 2; ++j) { const unsigned a[4] = {w[u][j].x, w[u][j].y, w[u][j].z, w[u][j].w};
#pragma unroll
                for (int k = 0; k < 4; ++k) { const float x0 = bflo(a[k]), x1 = bfhi(a[k]); s += x0 * x0 + x1 * x1; } }
            const float r = 1.f / sqrtf(wave_sum(s) * (1.f / AW) + EPS);
#pragma unroll
            for (int j = 0; j < 2; ++j) { const int c = 8 * (lane + 64 * j); const unsigned a[4] = {w[u][j].x, w[u][j].y, w[u][j].z, w[u][j].w}; unsigned o[4];
                const f32x4 g0 = *(const f32x4*)(ga + c), g1 = *(const f32x4*)(ga + c + 4); const float g[8] = {g0.x, g0.y, g0.z, g0.w, g1.x, g1.y, g1.z, g1.w};
#pragma unroll
                for (int k = 0; k < 4; ++k) o[k] = pk2(bflo(a[k]) * r * g[2 * k], bfhi(a[k]) * r * g[2 * k + 1]);
                *(v4u*)(MIXIN + (size_t)m * DM + HW + c) = (v4u){o[0], o[1], o[2], o[3]}; } }
    }
    LAS bf16* T = (LAS bf16*)F.lds; constexpr int TP = 1026;
    for (int unit = F.vcu; unit < BATCH * 64; unit += F.G) {
        const int b = unit >> 6, s0 = (unit & 63) * 32;
        __syncthreads();
#pragma unroll
        for (int i = 0; i < 8; ++i) { const int ch = tid & 3, c = (tid >> 2) + 128 * i;
            const v4u w = __builtin_nontemporal_load((const v4u*)(YT + ((size_t)c * BATCH + b) * SEQ + s0 + ch * 8)); const unsigned a[4] = {w.x, w.y, w.z, w.w};
#pragma unroll
            for (int k = 0; k < 4; ++k) { T[(ch * 8 + 2 * k) * TP + c] = (bf16)(a[k] & 0xffffu); T[(ch * 8 + 2 * k + 1) * TP + c] = (bf16)(a[k] >> 16); } }
        __syncthreads();
#pragma unroll
        for (int q = 0; q < 4; ++q) { const int sl = F.wave * 4 + q; unsigned v[8]; float s = 0.f;
#pragma unroll
            for (int k = 0; k < 8; ++k) { v[k] = *(const LAS unsigned*)(T + sl * TP + 2 * lane + 128 * k); const float x0 = bflo(v[k]), x1 = bfhi(v[k]); s += x0 * x0 + x1 * x1; }
            const float r = 1.f / sqrtf(wave_sum(s) * (1.f / HW) + EPS);
            bf16* orow = MIXIN + ((size_t)b * SEQ + s0 + sl) * DM;
#pragma unroll
            for (int k = 0; k < 8; ++k) { const int c = 2 * lane + 128 * k; const f32x2 g = *(const f32x2*)(gh + c);
                *(unsigned*)(orow + c) = pk2(bflo(v[k]) * r * g.x, bfhi(v[k]) * r * g.y); } }
    }
    __syncthreads();
}

__device__ __forceinline__ void p8_postmix(Frame& F) {
    const bf16* MIXED = (const bf16*)(F.ws + WS_MIXED); bf16* XN = (bf16*)(F.ws + WS_XN);
    const float* x = F.in[0]; const float* gpost = F.in[20]; const float* gpre = F.in[21]; bf16* H16 = (bf16*)(F.ws + WS_H16);
    const int gw = F.vcu * NWAVES + F.wave, NGW = F.G * NWAVES, lane = F.lane;
    for (int m = gw; m < M; m += NGW) {
        float mx[32]; float s = 0.f;
#pragma unroll
        for (int j = 0; j < 4; ++j) { const v4u w = *(const v4u*)(MIXED + (size_t)m * DM + 8 * (lane + 64 * j)); const unsigned a[4] = {w.x, w.y, w.z, w.w};
#pragma unroll
            for (int k = 0; k < 4; ++k) { mx[8 * j + 2 * k] = bflo(a[k]); mx[8 * j + 2 * k + 1] = bfhi(a[k]); s += mx[8 * j + 2 * k] * mx[8 * j + 2 * k] + mx[8 * j + 2 * k + 1] * mx[8 * j + 2 * k + 1]; } }
        const float r = 1.f / sqrtf(wave_sum(s) * (1.f / DM) + EPS);
        float s2 = 0.f;
#pragma unroll
        for (int j = 0; j < 4; ++j) { const int c = 8 * (lane + 64 * j);
#pragma unroll
            for (int hh = 0; hh < 2; ++hh) { const f32x4 xv = *(const f32x4*)(x + (size_t)m * DM + c + 4 * hh); const f32x4 g = *(const f32x4*)(gpost + c + 4 * hh);
                f32x4 hv; hv.x = xv.x + mx[8 * j + 4 * hh] * r * g.x; hv.y = xv.y + mx[8 * j + 4 * hh + 1] * r * g.y; hv.z = xv.z + mx[8 * j + 4 * hh + 2] * r * g.z; hv.w = xv.w + mx[8 * j + 4 * hh + 3] * r * g.w;
                mx[8 * j + 4 * hh] = hv.x; mx[8 * j + 4 * hh + 1] = hv.y; mx[8 * j + 4 * hh + 2] = hv.z; mx[8 * j + 4 * hh + 3] = hv.w;
                s2 += (hv.x * hv.x + hv.y * hv.y) + (hv.z * hv.z + hv.w * hv.w); } }
        const float s2t = wave_sum(s2); if (lane == 0) ((float*)(F.ws + WS_SS2))[m] = s2t;
        const float r2 = 1.f / sqrtf(s2t * (1.f / DM) + EPS);
#pragma unroll
        for (int j = 0; j < 4; ++j) { const int c = 8 * (lane + 64 * j); const f32x4 g0 = *(const f32x4*)(gpre + c), g1 = *(const f32x4*)(gpre + c + 4);
            { v4u hq; hq.x = pk2(mx[8 * j], mx[8 * j + 1]); hq.y = pk2(mx[8 * j + 2], mx[8 * j + 3]); hq.z = pk2(mx[8 * j + 4], mx[8 * j + 5]); hq.w = pk2(mx[8 * j + 6], mx[8 * j + 7]);
              *(v4u*)(H16 + (size_t)m * DM + c) = hq; }
            v4u o; o.x = pk2(mx[8 * j] * r2 * g0.x, mx[8 * j + 1] * r2 * g0.y); o.y = pk2(mx[8 * j + 2] * r2 * g0.z, mx[8 * j + 3] * r2 * g0.w);
            o.z = pk2(mx[8 * j + 4] * r2 * g1.x, mx[8 * j + 5] * r2 * g1.y); o.w = pk2(mx[8 * j + 6] * r2 * g1.z, mx[8 * j + 7] * r2 * g1.w);
            *(v4u*)(XN + (size_t)m * DM + c) = o; }
    }
}
__device__ __forceinline__ void p10_fixup(Frame& F) {
    const f32x4* BB = (const f32x4*)(F.ws + WS_BB); bf16* ACT = (bf16*)(F.ws + WS_ACT);
    const float* cw = F.in[23];
    constexpr int UB = 8, NE = 512 * DFF;
    const int stride = F.G * NTHR;
    for (int i0 = F.vcu * NTHR + F.tid; i0 < NE; i0 += stride * UB) {
        f32x4 v[UB]; float gn[UB], wn[UB]; int rr[UB], cc[UB]; bool ok[UB];
#pragma unroll
        for (int u = 0; u < UB; ++u) { int i = i0 + u * stride; ok[u] = (i < NE); i = ok[u] ? i : i0;
            const int q = i / DFF, c = i - q * DFF, chunk = q >> 1, last = q & 1; const int r = chunk * 64 + (last ? 63 : 0);
            const bool un = last ? (((r + 1) & (SEQ - 1)) != 0) : ((r & (SEQ - 1)) != 0);
            const int ni = un ? (last ? i + DFF : i - DFF) : i;
            v[u] = BB[i]; gn[u] = un ? BB[ni].y : 0.f; wn[u] = cw[(last ? 2 * DFF : 0) + c]; rr[u] = r; cc[u] = c; }
#pragma unroll
        for (int u = 0; u < UB; ++u) { const float pre = v[u].x + wn[u] * gn[u];
            if (ok[u]) ACT[(size_t)rr[u] * DFF + cc[u]] = (bf16)f2bf(pg8::gelu_tanh(pre) * v[u].z); }
    }
}
__device__ __forceinline__ void p12_final(Frame& F) {
    const bf16* FB = (const bf16*)(F.ws + WS_F); const bf16* H16 = (const bf16*)(F.ws + WS_H16); const float* g = F.in[26]; float* out = F.out;
    const int gw = F.vcu * NWAVES + F.wave, NGW = F.G * NWAVES, lane = F.lane;
    for (int m = gw; m < M; m += NGW) {
        float fx[32]; float s = 0.f; v4u hw[4];
#pragma unroll
        for (int j = 0; j < 4; ++j) { const v4u w = *(const v4u*)(FB + (size_t)m * DM + 8 * (lane + 64 * j)); hw[j] = *(const v4u*)(H16 + (size_t)m * DM + 8 * (lane + 64 * j)); const unsigned a[4] = {w.x, w.y, w.z, w.w};
#pragma unroll
            for (int k = 0; k < 4; ++k) { fx[8 * j + 2 * k] = bflo(a[k]); fx[8 * j + 2 * k + 1] = bfhi(a[k]); s += fx[8 * j + 2 * k] * fx[8 * j + 2 * k] + fx[8 * j + 2 * k + 1] * fx[8 * j + 2 * k + 1]; } }
        const float r = 1.f / sqrtf(wave_sum(s) * (1.f / DM) + EPS);
#pragma unroll
        for (int j = 0; j < 4; ++j) { const int c = 8 * (lane + 64 * j); const unsigned hh4[4] = {hw[j].x, hw[j].y, hw[j].z, hw[j].w};
#pragma unroll
            for (int hh = 0; hh < 2; ++hh) { float* p = out + (size_t)m * DM + c + 4 * hh; const f32x4 gg = *(const f32x4*)(g + c + 4 * hh);
                f32x4 ov; ov.x = bflo(hh4[2 * hh]) + fx[8 * j + 4 * hh] * r * gg.x; ov.y = bfhi(hh4[2 * hh]) + fx[8 * j + 4 * hh + 1] * r * gg.y;
                ov.z = bflo(hh4[2 * hh + 1]) + fx[8 * j + 4 * hh + 2] * r * gg.z; ov.w = bfhi(hh4[2 * hh + 1]) + fx[8 * j + 4 * hh + 3] * r * gg.w;
                *(f32x4*)p = ov; } }
    }
}

struct Args { const float* in[27]; float* out; unsigned char* ws; int ph_lo, ph_hi; };
template <bool COOP>
__global__ void __launch_bounds__(NTHR, 2) mk_fwd(Args args) {
    extern __shared__ __attribute__((aligned(16))) unsigned char lds[];
    Frame F;
    F.lds = (LAS unsigned char*)lds; F.ldsg = (char*)lds;
    F.tid = threadIdx.x; F.lane = F.tid & 63; F.wave = __builtin_amdgcn_readfirstlane(F.tid >> 6);
    F.G = gridDim.x; { const int bx = blockIdx.x; F.vcu = (F.G % 8 == 0) ? (bx % 8) * (F.G / 8) + bx / 8 : bx; }
#pragma unroll
    for (int i = 0; i < 27; ++i) F.in[i] = args.in[i];
    F.out = args.out; F.ws = args.ws;
    unsigned char* ws = args.ws;
    const int lo = args.ph_lo, hi = args.ph_hi;
    volatile LAS unsigned* MISC = (volatile LAS unsigned*)(F.lds + 131072 + 320);
    XcdBarrier bar; bar.bar = (unsigned*)ws; bar.x = 0; bar.st = nullptr;
    if (COOP) { if (F.tid < 32) MISC[F.tid] = 0u; __syncthreads(); bar = xcd_barrier_post((unsigned*)ws, MISC + 8);
        p0_pre(F);
        cg::this_grid().sync(); }
#ifndef PROBE_REP
#define PROBE_REP 0
#endif
#define REP(k) for (int rep_ = 0; rep_ < 1 + ((PROBE_REP >> (k)) & 1); ++rep_)
#define IN(k) (lo <= (k) && (k) < hi)
#define SEAM(k) do { if (COOP && IN((k) + 1)) xcd_barrier(bar); } while (0)
#ifndef SKIP_P0
    if (IN(0)) { REP(0) p0_prologue(F); SEAM(0); }
#endif
    if (IN(1)) { pg8::Gemm g{(const bf16*)(ws + WS_XN), (const bf16*)(ws + WS_WIN), M, INWP, DM}; pg8::StaticOrder S; S.init(M, INWP, F.G, (int)blockIdx.x);
        pg8::EpiStore E{(bf16*)(ws + WS_PROJ), INWP};
        pg8::gemm_phase<pg8::EpiStore, pg8::StaticOrder, true, true>(F.lds, g, S, E); SEAM(1); }
    if (IN(2)) { REP(2) { p2_hyena_prep(F); p2_mla_prep(F); p2_filter_out(F); } SEAM(2); }
    if (IN(3)) {
#ifndef SKIP_LC
        REP(3) p4_longconv(F);
#endif
        { pg8::Gemm g{(const bf16*)(ws + WS_CQN), (const bf16*)(ws + WS_WUQ), M, NQ, QLR}; pg8::StaticOrder S; S.init(M, NQ, F.G, (int)blockIdx.x);
          pg8::EpiStore E{(bf16*)(ws + WS_Q), NQ, true};
          pg8::gemm_phase<pg8::EpiStore, pg8::StaticOrder, true, true>(F.lds, g, S, E); }
        { pg8::Gemm g{(const bf16*)(ws + WS_CKVN), (const bf16*)(ws + WS_WUKV), M, NKV, KVLR}; pg8::StaticOrder S; S.init(M, NKV, F.G, (int)blockIdx.x);
          pg8::EpiStore E{(bf16*)(ws + WS_KV), NKV, true};
          pg8::gemm_phase<pg8::EpiStore, pg8::StaticOrder, true, true>(F.lds, g, S, E); }
        SEAM(3); }
    #ifndef SKIP_ATT
    if (IN(4)) { REP(4) p5_attention(F); SEAM(4); }
#endif
    if (IN(5)) { REP(5) p6_mixnorm(F); SEAM(5); }
    const bool fused = (F.G == 256);
    if (IN(6)) { pg8::Gemm g{(const bf16*)(ws + WS_MIXIN), (const bf16*)(ws + WS_WOUT), M, DM, DM}; pg8::StaticOrder S; S.init(M, DM, F.G, (int)blockIdx.x);
        if (fused) { pg8::EpiMixRes E{(bf16*)(ws + WS_MIXED), F.in[0], F.in[20], (bf16*)(ws + WS_H16), (float*)(ws + WS_SS1), (float*)(ws + WS_SS2), (unsigned*)(ws + WS_CNT), DM, EPS};
            pg8::gemm_phase<pg8::EpiMixRes, pg8::StaticOrder, true, true>(F.lds, g, S, E); }
        else { pg8::EpiStore E{(bf16*)(ws + WS_MIXED), DM};
            pg8::gemm_phase<pg8::EpiStore, pg8::StaticOrder, true, true>(F.lds, g, S, E); if (COOP) xcd_barrier(bar); p8_postmix(F); }
        SEAM(7); }
#ifndef SKIP_GEGLU
    if (IN(8)) { pg8::Gemm g{(const bf16*)(ws + WS_H16), (const bf16*)(ws + WS_WUP), M, 2 * DFF, DM}; pg8::StaticOrder S; S.init(M, 2 * DFF, F.G, (int)blockIdx.x);
        pg8::EpiGeglu E{(bf16*)(ws + WS_ACT), F.in[23], F.in[24], (pg8::f32x4*)(ws + WS_BB), DFF, (const float*)(ws + WS_SS2), EPS};
        pg8::gemm_phase<pg8::EpiGeglu, pg8::StaticOrder, true, true>(F.lds, g, S, E); SEAM(8); }
#endif
    if (IN(9)) { REP(9) p10_fixup(F); SEAM(9); }
    if (IN(10)) { pg8::Gemm g{(const bf16*)(ws + WS_ACT), (const bf16*)(ws + WS_WDOWN), M, DM, DFF}; pg8::StaticOrder S; S.init(M, DM, F.G, (int)blockIdx.x);
        if (fused) { pg8::EpiFinal E{(bf16*)(ws + WS_F), (const bf16*)(ws + WS_H16), F.in[26], F.out, (float*)(ws + WS_SS3), (unsigned*)(ws + WS_CNT2), DM, EPS};
            pg8::gemm_phase<pg8::EpiFinal, pg8::StaticOrder, true, true>(F.lds, g, S, E); }
        else { pg8::EpiStore E{(bf16*)(ws + WS_F), DM};
            pg8::gemm_phase<pg8::EpiStore, pg8::StaticOrder, true, true>(F.lds, g, S, E); if (COOP) xcd_barrier(bar); p12_final(F); } }
#undef IN
#undef SEAM
}

extern "C" void kernel_launch(void* const* d_in, const int* in_sizes, int n_in, void* d_out, int out_size, void* d_ws, size_t ws_size, hipStream_t stream) {
    static int grid = 0;
    if (grid == 0) {
        if (n_in != 27 || in_sizes[0] != M * DM || out_size != M * DM || ws_size < WS_END) { fprintf(stderr, "kernel_launch: unexpected shapes: n_in %d in0 %d out %d ws %zu (need %zu)\n", n_in, n_in > 0 ? in_sizes[0] : -1, out_size, ws_size, (size_t)WS_END); grid = -1; return; }
        int dev = 0, cus = 0;
        if (hipGetDevice(&dev) != hipSuccess || hipDeviceGetAttribute(&cus, hipDeviceAttributeMultiprocessorCount, dev) != hipSuccess) { grid = -1; return; }
        if (hipFuncSetAttribute((const void*)mk_fwd<true>, hipFuncAttributeMaxDynamicSharedMemorySize, LDS_BYTES) != hipSuccess ||
            hipFuncSetAttribute((const void*)mk_fwd<false>, hipFuncAttributeMaxDynamicSharedMemorySize, LDS_BYTES) != hipSuccess) { fprintf(stderr, "kernel_launch: hipFuncSetAttribute failed\n"); grid = -1; return; }
        int per_cu = 0;
        if (hipOccupancyMaxActiveBlocksPerMultiprocessor(&per_cu, (const void*)mk_fwd<true>, NTHR, LDS_BYTES) != hipSuccess || per_cu < 1) { fprintf(stderr, "kernel_launch: occupancy query says %d\n", per_cu); }
        (void)hipGetLastError();
        grid = cus;
    }
    if (grid < 0) return;
    Args a{};
    for (int i = 0; i < 27; ++i) a.in[i] = (const float*)d_in[i];
    a.out = (float*)d_out; a.ws = (unsigned char*)d_ws;
    if (MK_N_LAUNCHES == 1) {
        a.ph_lo = 0; a.ph_hi = 12;
        if (hipMemsetAsync(d_ws, 0, CTL_BYTES, stream) != hipSuccess) { fprintf(stderr, "kernel_launch: memset failed\n"); return; }
        void* kargs[] = {&a};
        hipError_t e = hipLaunchCooperativeKernel((const void*)mk_fwd<true>, dim3(grid), dim3(NTHR), kargs, LDS_BYTES, stream);
        if (e != hipSuccess) fprintf(stderr, "kernel_launch: cooperative launch failed: %s (grid %d)\n", hipGetErrorString(e), grid);
    } else {
        for (int p = 0; p < 12; ++p) { a.ph_lo = p; a.ph_hi = p + 1;
            hipLaunchKernelGGL(mk_fwd<false>, dim3(grid), dim3(NTHR), LDS_BYTES, stream, a);
            const hipError_t le = hipPeekAtLastError();
            if (le != hipSuccess) { fprintf(stderr, "kernel_launch: launch %d failed: %s\n", p, hipGetErrorName(le)); break; } }
    }
}
```

```cpp
#include <hip/hip_runtime.h>
#include <hip/hip_cooperative_groups.h>
#include <cstdio>
#include <cstdint>
namespace cg = cooperative_groups;
#ifndef MK_N_LAUNCHES
#define MK_N_LAUNCHES 1
#endif
namespace pg8 {
#define PG8_LAS __attribute__((address_space(3)))
typedef unsigned short bf16_t;
typedef short bf16x8 __attribute__((ext_vector_type(8)));
typedef float f32x4 __attribute__((ext_vector_type(4)));
typedef unsigned u32x4 __attribute__((ext_vector_type(4)));
constexpr int BM = 256, BK = 64, HALF = 128, HTB = HALF * BK * 2  , STAGE_BYTES = 8 * HTB, NXCD = 8, WGM = 8;

__host__ __device__ __forceinline__ int lds_byte(int r, int c) { const int st = (r >> 4) * 2 + (c >> 5), rr = r & 15, cc = c & 31, ob = rr * 64 + cc * 2; return st * 1024 + (ob ^ (((ob >> 9) & 1) << 5)); }
__host__ __device__ __forceinline__ void stage_rc(int b, int& R, int& C) { const int st = b / 1024, sb = b % 1024, swz = sb ^ (((sb >> 9) & 1) << 5); R = (st >> 1) * 16 + swz / 64; C = (st & 1) * 32 + (swz % 64) / 2; }
__host__ __device__ __forceinline__ int perm32(int rho) { const int n = rho >> 4, i = rho & 15; return 8 * (i >> 2) + 4 * n + (i & 3); }

struct Unit { int pm, pn; };
struct Gemm { const bf16_t* A; const bf16_t* Bt; int M, N, K; };

struct StaticOrder {
    int nM, nN, nwg, G, c;
    __host__ __device__ void init(int M, int N, int G_, int c_) { nM = M / BM; nN = N / BM; nwg = nM * nN; G = G_; c = c_; }
    __host__ __device__ bool next(int i, Unit& u) const {
        const long L = (long)i * G + c; if (L >= nwg) return false;
        int wgid = (int)L; { const int q = nwg / NXCD, r = nwg % NXCD, xcd = wgid % NXCD, off = wgid / NXCD; wgid = (xcd < r ? xcd * (q + 1) : r * (q + 1) + (xcd - r) * q) + off; }
        const int nig = WGM * nN, gid = wgid / nig, fm = gid * WGM, gsz = (nM - fm) < WGM ? (nM - fm) : WGM;
        u.pm = fm + ((wgid % nig) % gsz); u.pn = (wgid % nig) / gsz; return true;
    }
    __device__ __forceinline__ void a_ready(const Unit&) const {}
    __device__ __forceinline__ void done(const Unit&) const {}
};

__device__ __forceinline__ unsigned cvt_pk_bf16(float lo, float hi) { unsigned r; asm volatile("v_cvt_pk_bf16_f32 %0, %1, %2" : "=v"(r) : "v"(lo), "v"(hi)); return r; }
typedef float f32x2 __attribute__((ext_vector_type(2)));

struct EpiStore {
    static constexpr bool PERM = true, AFTER_DRAIN = false;
    bf16_t* O; int ldc;
    __device__ __forceinline__ void operator()(const f32x4 (&acc)[2][2][4][2], const Unit& u, int wr, int wc, int fr, int fq) const {
        const int row0 = u.pm * BM + wr * 64 + fr; const int col0 = u.pn * BM + wc * 32 + 8 * fq;
#pragma unroll
        for (int ai = 0; ai < 2; ++ai)
#pragma unroll
            for (int m = 0; m < 4; ++m) { bf16_t* rowp = O + (size_t)(row0 + ai * HALF + m * 16) * ldc + col0;
#pragma unroll
                for (int bj = 0; bj < 2; ++bj) { const f32x4 v0 = acc[ai][bj][m][0], v1 = acc[ai][bj][m][1];
                    u32x4 w; w.x = cvt_pk_bf16(v0[0], v0[1]); w.y = cvt_pk_bf16(v0[2], v0[3]); w.z = cvt_pk_bf16(v1[0], v1[1]); w.w = cvt_pk_bf16(v1[2], v1[3]);
                    *(u32x4*)(rowp + bj * HALF) = w; } }
    }
};

struct EpiMixRes {
    static constexpr bool PERM = true, AFTER_DRAIN = false;
    bf16_t* MIXED; const float* x; const float* gpost; bf16_t* H16; float* SS1; float* SS2; unsigned* CNT; int ldc; float eps;
    __device__ __forceinline__ void fin8(const f32x4& v0, const f32x4& v1, float r1, size_t o, int col, float& s2) const {
        const f32x4 x0 = __builtin_nontemporal_load((const f32x4*)(x + o)), x1 = __builtin_nontemporal_load((const f32x4*)(x + o + 4)), g0 = *(const f32x4*)(gpost + col), g1 = *(const f32x4*)(gpost + col + 4);
        const f32x4 h0 = x0 + (v0 * r1) * g0, h1 = x1 + (v1 * r1) * g1;
        s2 += (h0[0] * h0[0] + h0[1] * h0[1]) + (h0[2] * h0[2] + h0[3] * h0[3]) + (h1[0] * h1[0] + h1[1] * h1[1]) + (h1[2] * h1[2] + h1[3] * h1[3]);
        u32x4 w; w.x = cvt_pk_bf16(h0[0], h0[1]); w.y = cvt_pk_bf16(h0[2], h0[3]); w.z = cvt_pk_bf16(h1[0], h1[1]); w.w = cvt_pk_bf16(h1[2], h1[3]);
        *(u32x4*)(H16 + o) = w;
    }
    __device__ __forceinline__ void operator()(const f32x4 (&acc)[2][2][4][2], const Unit& u, int wr, int wc, int fr, int fq) const {
        const bool second = (u.pn >= 4);
        const int row0 = u.pm * BM + wr * 64 + fr; const int col0 = u.pn * BM + wc * 32 + 8 * fq;
#pragma unroll
        for (int ai = 0; ai < 2; ++ai)
#pragma unroll
            for (int m = 0; m < 4; ++m) { float s = 0.f;
#pragma unroll
                for (int bj = 0; bj < 2; ++bj)
#pragma unroll
                    for (int n = 0; n < 2; ++n) { const f32x4 v = acc[ai][bj][m][n]; s += (v[0] * v[0] + v[1] * v[1]) + (v[2] * v[2] + v[3] * v[3]); }
                s += __shfl_xor(s, 16); s += __shfl_xor(s, 32);
                if (fq == 0) (void)__hip_atomic_fetch_add(SS1 + row0 + ai * HALF + m * 16, s, __ATOMIC_RELAXED, __HIP_MEMORY_SCOPE_AGENT); }
        if (!second) {
#pragma unroll
            for (int ai = 0; ai < 2; ++ai)
#pragma unroll
                for (int m = 0; m < 4; ++m) { bf16_t* rowp = MIXED + (size_t)(row0 + ai * HALF + m * 16) * ldc + col0;
#pragma unroll
                    for (int bj = 0; bj < 2; ++bj) { const f32x4 v0 = acc[ai][bj][m][0], v1 = acc[ai][bj][m][1];
                        u32x4 w; w.x = cvt_pk_bf16(v0[0], v0[1]); w.y = cvt_pk_bf16(v0[2], v0[3]); w.z = cvt_pk_bf16(v1[0], v1[1]); w.w = cvt_pk_bf16(v1[2], v1[3]);
                        *(u32x4*)(rowp + bj * HALF) = w; } }
            return;
        }
        asm volatile("s_waitcnt vmcnt(0)" ::: "memory");
        __builtin_amdgcn_s_barrier();
        if (threadIdx.x == 0) {
            __builtin_amdgcn_fence(__ATOMIC_RELEASE, "agent");
            (void)__hip_atomic_fetch_add(CNT + 64 * u.pm, 1u, __ATOMIC_RELAXED, __HIP_MEMORY_SCOPE_AGENT);
            unsigned sp = 0;
            while (__hip_atomic_load(CNT + 64 * u.pm, __ATOMIC_RELAXED, __HIP_MEMORY_SCOPE_AGENT) < 4u) { __builtin_amdgcn_s_sleep(2); if (++sp > (1u << 22)) break; }
            __builtin_amdgcn_fence(__ATOMIC_ACQUIRE, "agent");
        }
        __builtin_amdgcn_s_barrier();
        asm volatile("" ::: "memory");
#pragma unroll
        for (int ai = 0; ai < 2; ++ai)
#pragma unroll
            for (int m = 0; m < 4; ++m) { const int row = row0 + ai * HALF + m * 16;
                const float r1 = 1.f / sqrtf(__hip_atomic_load(SS1 + row, __ATOMIC_RELAXED, __HIP_MEMORY_SCOPE_AGENT) * (1.f / 2048.f) + eps);
                float s2 = 0.f;
#pragma unroll
                for (int bj = 0; bj < 2; ++bj) {
                    const int col = col0 + bj * HALF; const size_t o = (size_t)row * ldc + col;
                    fin8(acc[ai][bj][m][0], acc[ai][bj][m][1], r1, o, col, s2);
                    const int colp = col - 4 * BM; const size_t op = (size_t)row * ldc + colp;
                    const u32x4 w = *(const u32x4*)(MIXED + op);
                    const f32x4 p0 = {__builtin_bit_cast(float, w.x << 16), __builtin_bit_cast(float, w.x & 0xffff0000u), __builtin_bit_cast(float, w.y << 16), __builtin_bit_cast(float, w.y & 0xffff0000u)};
                    const f32x4 p1 = {__builtin_bit_cast(float, w.z << 16), __builtin_bit_cast(float, w.z & 0xffff0000u), __builtin_bit_cast(float, w.w << 16), __builtin_bit_cast(float, w.w & 0xffff0000u)};
                    fin8(p0, p1, r1, op, colp, s2); }
                s2 += __shfl_xor(s2, 16); s2 += __shfl_xor(s2, 32);
                if (fq == 0) (void)__hip_atomic_fetch_add(SS2 + row, s2, __ATOMIC_RELAXED, __HIP_MEMORY_SCOPE_AGENT); }
    }
};

struct EpiFinal {
    static constexpr bool PERM = true, AFTER_DRAIN = false;
    bf16_t* FB; const bf16_t* H16; const float* gain; float* out; float* SS; unsigned* CNT; int ldc; float eps;
    __device__ __forceinline__ void fin8(const f32x4& v0, const f32x4& v1, float r, size_t o, int col) const {
        const u32x4 hw = __builtin_nontemporal_load((const u32x4*)(H16 + o)); const f32x4 g0 = *(const f32x4*)(gain + col), g1 = *(const f32x4*)(gain + col + 4);
        const f32x4 h0 = {__builtin_bit_cast(float, hw.x << 16), __builtin_bit_cast(float, hw.x & 0xffff0000u), __builtin_bit_cast(float, hw.y << 16), __builtin_bit_cast(float, hw.y & 0xffff0000u)};
        const f32x4 h1 = {__builtin_bit_cast(float, hw.z << 16), __builtin_bit_cast(float, hw.z & 0xffff0000u), __builtin_bit_cast(float, hw.w << 16), __builtin_bit_cast(float, hw.w & 0xffff0000u)};
        __builtin_nontemporal_store(h0 + (v0 * r) * g0, (f32x4*)(out + o)); __builtin_nontemporal_store(h1 + (v1 * r) * g1, (f32x4*)(out + o + 4));
    }
    __device__ __forceinline__ void operator()(const f32x4 (&acc)[2][2][4][2], const Unit& u, int wr, int wc, int fr, int fq) const {
        const bool second = (u.pn >= 4);
        const int row0 = u.pm * BM + wr * 64 + fr; const int col0 = u.pn * BM + wc * 32 + 8 * fq;
#pragma unroll
        for (int ai = 0; ai < 2; ++ai)
#pragma unroll
            for (int m = 0; m < 4; ++m) { float s = 0.f;
#pragma unroll
                for (int bj = 0; bj < 2; ++bj)
#pragma unroll
                    for (int n = 0; n < 2; ++n) { const f32x4 v = acc[ai][bj][m][n]; s += (v[0] * v[0] + v[1] * v[1]) + (v[2] * v[2] + v[3] * v[3]); }
                s += __shfl_xor(s, 16); s += __shfl_xor(s, 32);
                if (fq == 0) (void)__hip_atomic_fetch_add(SS + row0 + ai * HALF + m * 16, s, __ATOMIC_RELAXED, __HIP_MEMORY_SCOPE_AGENT); }
        if (!second) {
#pragma unroll
            for (int ai = 0; ai < 2; ++ai)
#pragma unroll
                for (int m = 0; m < 4; ++m) { bf16_t* rowp = FB + (size_t)(row0 + ai * HALF + m * 16) * ldc + col0;
#pragma unroll
                    for (int bj = 0; bj < 2; ++bj) { const f32x4 v0 = acc[ai][bj][m][0], v1 = acc[ai][bj][m][1];
                        u32x4 w; w.x = cvt_pk_bf16(v0[0], v0[1]); w.y = cvt_pk_bf16(v0[2], v0[3]); w.z = cvt_pk_bf16(v1[0], v1[1]); w.w = cvt_pk_bf16(v1[2], v1[3]);
                        *(u32x4*)(rowp + bj * HALF) = w; } }
            return;
        }
        asm volatile("s_waitcnt vmcnt(0)" ::: "memory");
        __builtin_amdgcn_s_barrier();
        if (threadIdx.x == 0) {
            __builtin_amdgcn_fence(__ATOMIC_RELEASE, "agent");
            (void)__hip_atomic_fetch_add(CNT + 64 * u.pm, 1u, __ATOMIC_RELAXED, __HIP_MEMORY_SCOPE_AGENT);
            unsigned sp = 0;
            while (__hip_atomic_load(CNT + 64 * u.pm, __ATOMIC_RELAXED, __HIP_MEMORY_SCOPE_AGENT) < 4u) { __builtin_amdgcn_s_sleep(2); if (++sp > (1u << 22)) break; }
            __builtin_amdgcn_fence(__ATOMIC_ACQUIRE, "agent");
        }
        __builtin_amdgcn_s_barrier();
        asm volatile("" ::: "memory");
#pragma unroll
        for (int ai = 0; ai < 2; ++ai)
#pragma unroll
            for (int m = 0; m < 4; ++m) { const int row = row0 + ai * HALF + m * 16;
                const float r = 1.f / sqrtf(__hip_atomic_load(SS + row, __ATOMIC_RELAXED, __HIP_MEMORY_SCOPE_AGENT) * (1.f / 2048.f) + eps);
#pragma unroll
                for (int bj = 0; bj < 2; ++bj) {
                    const int col = col0 + bj * HALF; const size_t o = (size_t)row * ldc + col;
                    fin8(acc[ai][bj][m][0], acc[ai][bj][m][1], r, o, col);
                    const int colp = col - 4 * BM; const size_t op = (size_t)row * ldc + colp;
                    const u32x4 w = __builtin_nontemporal_load((const u32x4*)(FB + op));
                    const f32x4 p0 = {__builtin_bit_cast(float, w.x << 16), __builtin_bit_cast(float, w.x & 0xffff0000u), __builtin_bit_cast(float, w.y << 16), __builtin_bit_cast(float, w.y & 0xffff0000u)};
                    const f32x4 p1 = {__builtin_bit_cast(float, w.z << 16), __builtin_bit_cast(float, w.z & 0xffff0000u), __builtin_bit_cast(float, w.w << 16), __builtin_bit_cast(float, w.w & 0xffff0000u)};
                    fin8(p0, p1, r, op, colp); } }
    }
};

__device__ __forceinline__ float gelu_tanh(float x) {
    const float z = 0.7978845608028654f * (x + 0.044715f * x * x * x);
    const float e = __builtin_amdgcn_exp2f(-2.885390081777927f * z);
    return x * __builtin_amdgcn_rcpf(1.f + e);
}
#ifndef MK_DPP
#define MK_DPP 1
#endif
#if MK_DPP
__device__ __forceinline__ float ror1(float v) { return __builtin_bit_cast(float, __builtin_amdgcn_update_dpp(0, __builtin_bit_cast(int, v), 0x121, 0xf, 0xf, true)); }
__device__ __forceinline__ float rol1(float v) { return __builtin_bit_cast(float, __builtin_amdgcn_update_dpp(0, __builtin_bit_cast(int, v), 0x12f, 0xf, 0xf, true)); }
#else
__device__ __forceinline__ float ror1(float v) { const int l = threadIdx.x & 63; return __shfl(v, (l & 48) | ((l - 1) & 15)); }
__device__ __forceinline__ float rol1(float v) { const int l = threadIdx.x & 63; return __shfl(v, (l & 48) | ((l + 1) & 15)); }
#endif

struct EpiGeglu {
    static constexpr bool PERM = true, AFTER_DRAIN = false;
    bf16_t* ACT; const float* cw; const float* cb; f32x4* BB; int dff; const float* SS2; float eps;
    __device__ __forceinline__ void operator()(const f32x4 (&acc)[2][2][4][2], const Unit& u, int wr, int wc, int fr, int fq) const {
        const int gc0 = u.pn * 128 + wc * 32 + 8 * fq;
        f32x2 w0[4], w1[4], w2[4], bb[4];
        { const f32x4 a0 = *(const f32x4*)(cw + gc0), a1 = *(const f32x4*)(cw + gc0 + 4), b0 = *(const f32x4*)(cw + dff + gc0), b1 = *(const f32x4*)(cw + dff + gc0 + 4);
          const f32x4 c0 = *(const f32x4*)(cw + 2 * dff + gc0), c1 = *(const f32x4*)(cw + 2 * dff + gc0 + 4), d0 = *(const f32x4*)(cb + gc0), d1 = *(const f32x4*)(cb + gc0 + 4);
          w0[0] = (f32x2){a0.x, a0.y}; w0[1] = (f32x2){a0.z, a0.w}; w0[2] = (f32x2){a1.x, a1.y}; w0[3] = (f32x2){a1.z, a1.w};
          w1[0] = (f32x2){b0.x, b0.y}; w1[1] = (f32x2){b0.z, b0.w}; w1[2] = (f32x2){b1.x, b1.y}; w1[3] = (f32x2){b1.z, b1.w};
          w2[0] = (f32x2){c0.x, c0.y}; w2[1] = (f32x2){c0.z, c0.w}; w2[2] = (f32x2){c1.x, c1.y}; w2[3] = (f32x2){c1.z, c1.w};
          bb[0] = (f32x2){d0.x, d0.y}; bb[1] = (f32x2){d0.z, d0.w}; bb[2] = (f32x2){d1.x, d1.y}; bb[3] = (f32x2){d1.z, d1.w}; }
        const f32x2 K1 = (f32x2){-2.302208198f, -2.302208198f}, K2 = (f32x2){-0.102943239f, -0.102943239f}, ONE = (f32x2){1.f, 1.f}, ZERO = (f32x2){0.f, 0.f};
        const bool f0 = (fr == 0), f15 = (fr == 15);
#pragma unroll
        for (int ai = 0; ai < 2; ++ai) {
            const int chunk = u.pm * 4 + ai * 2 + wr; const int rbase = chunk * 64;
            f32x4* pF = BB + (size_t)(chunk * 2) * dff + gc0; f32x4* pL = pF + dff;
            unsigned pk[4][4];
            f32x2 rs[4];
#pragma unroll
            for (int m = 0; m < 4; ++m) { const float t = 1.f / sqrtf(SS2[rbase + m * 16 + fr] * (1.f / 2048.f) + eps); rs[m] = (f32x2){t, t}; }
#pragma unroll
            for (int jp = 0; jp < 4; ++jp) { const int n = jp >> 1, e0 = (jp & 1) * 2;
                f32x2 G[4], R[4], L[4];
#pragma unroll
                for (int m = 0; m < 4; ++m) { G[m] = (f32x2){acc[ai][0][m][n][e0], acc[ai][0][m][n][e0 + 1]} * rs[m];
                    R[m] = (f32x2){ror1(G[m].x), ror1(G[m].y)}; L[m] = (f32x2){rol1(G[m].x), rol1(G[m].y)}; }
#pragma unroll
                for (int m = 0; m < 4; ++m) {
                    const f32x2 uu = (f32x2){acc[ai][1][m][n][e0], acc[ai][1][m][n][e0 + 1]} * rs[m];
                    const f32x2 gup = f0 ? (m > 0 ? R[m > 0 ? m - 1 : 0] : ZERO) : R[m];
                    const f32x2 gdn = f15 ? (m < 3 ? L[m < 3 ? m + 1 : 3] : ZERO) : L[m];
                    const f32x2 pre = w0[jp] * gup + (w1[jp] * G[m] + (w2[jp] * gdn + bb[jp]));
                    const f32x2 a = pre * ((pre * pre) * K2 + K1);
                    f32x2 e; e.x = __builtin_amdgcn_exp2f(a.x); e.y = __builtin_amdgcn_exp2f(a.y);
                    const f32x2 d = e + ONE;
                    f32x2 r; r.x = __builtin_amdgcn_rcpf(d.x); r.y = __builtin_amdgcn_rcpf(d.y);
                    const f32x2 o = (pre * uu) * r;
                    pk[m][jp] = cvt_pk_bf16(o.x, o.y);
                    if (m == 0) { if (f0) { pF[2 * jp] = (f32x4){pre.x, G[m].x, uu.x, 0.f}; pF[2 * jp + 1] = (f32x4){pre.y, G[m].y, uu.y, 0.f}; } }
                    if (m == 3) { if (f15) { pL[2 * jp] = (f32x4){pre.x, G[m].x, uu.x, 0.f}; pL[2 * jp + 1] = (f32x4){pre.y, G[m].y, uu.y, 0.f}; } }
                }
            }
#pragma unroll
            for (int m = 0; m < 4; ++m) { u32x4 w; w.x = pk[m][0]; w.y = pk[m][1]; w.z = pk[m][2]; w.w = pk[m][3];
                __builtin_nontemporal_store(w, (u32x4*)(ACT + (size_t)(rbase + m * 16 + fr) * dff + gc0)); }
        }
    }
};

template <class Epi, class Sched, bool ALIGN_EPI = false, bool SP2 = false>
__device__ __forceinline__ void gemm_phase(PG8_LAS unsigned char* lds, const Gemm g, const Sched& S, const Epi& E) {
    const int tid = threadIdx.x, wid = __builtin_amdgcn_readfirstlane(tid >> 6), lane = tid & 63, wr = wid >> 2, wc = wid & 3, fr = lane & 15, fq = lane >> 4;
    const int K = g.K, nt = K / BK;
    unsigned voffA[2], voffB[2];
#pragma unroll
    for (int i = 0; i < 2; ++i) { int R, C; stage_rc(tid * 16 + i * 8192, R, C); const int Rb = Epi::PERM ? ((R & ~31) + perm32(R & 31)) : R;
        voffA[i] = (unsigned)(R * K + C) * 2u; voffB[i] = (unsigned)(Rb * K + C) * 2u; }
    const size_t kstep = (size_t)(BK * 2);
    const size_t hstep = (size_t)HALF * K * 2;
    const size_t tstep = 2 * hstep;
    const unsigned ldsw = (unsigned)wid * 1024u;
    const int aoff = lds_byte(wr * 64 + fr, fq * 8), boff = lds_byte(wc * 32 + fr, fq * 8);
#define PG8_SA(b, h) (((b) * 2 + (h)) * HTB)
#define PG8_SB(b, h) ((4 + (b) * 2 + (h)) * HTB)
#define PG8_STAGE(bufoff, gbase, voff) do { _Pragma("unroll") for (int _i = 0; _i < 2; ++_i) \
        __builtin_amdgcn_global_load_lds((const unsigned*)((const char*)(gbase) + (voff)[_i]), (PG8_LAS unsigned*)(lds + (bufoff) + ldsw + _i * 8192), 16, 0, 0); } while (0)
#define PG8_LDA(dst, b, h) do { _Pragma("unroll") for (int m = 0; m < 4; ++m) _Pragma("unroll") for (int k = 0; k < 2; ++k) dst[m][k] = *(const PG8_LAS bf16x8*)(lds + PG8_SA(b, h) + aoff + m * 2048 + k * 1024); } while (0)
#define PG8_LDB(dst, b, h) do { _Pragma("unroll") for (int n = 0; n < 2; ++n) _Pragma("unroll") for (int k = 0; k < 2; ++k) dst[n][k] = *(const PG8_LAS bf16x8*)(lds + PG8_SB(b, h) + boff + n * 2048 + k * 1024); } while (0)
#define PG8_MMA(ai, bj, At, Bt) do { __builtin_amdgcn_s_setprio(1); _Pragma("unroll") for (int m = 0; m < 4; ++m) _Pragma("unroll") for (int n = 0; n < 2; ++n) _Pragma("unroll") for (int k = 0; k < 2; ++k) \
        acc[ai][bj][m][n] = __builtin_amdgcn_mfma_f32_16x16x32_bf16(Bt[n][k], At[m][k], acc[ai][bj][m][n], 0, 0, 0); __builtin_amdgcn_s_setprio(0); } while (0)
#define PG8_WAIT_V(n) asm volatile("s_waitcnt vmcnt(" #n ")" ::: "memory")
#define PG8_WAIT_L(n) asm volatile("s_waitcnt lgkmcnt(" #n ")" ::: "memory")
#define PG8_BAR __builtin_amdgcn_s_barrier()
#define PG8_SCHED __builtin_amdgcn_sched_barrier(0)
    Unit cur, nxt; int ui = 0;
    if (!S.next(0, cur)) return;
    f32x4 acc[2][2][4][2];
#pragma unroll
    for (int a = 0; a < 2; ++a)
#pragma unroll
        for (int b = 0; b < 2; ++b)
#pragma unroll
            for (int m = 0; m < 4; ++m)
#pragma unroll
                for (int n = 0; n < 2; ++n) acc[a][b][m][n] = (f32x4){0.f, 0.f, 0.f, 0.f};
    bf16x8 At[4][2], B0[2][2], B1[2][2];
    const char* cA = (const char*)g.A + (size_t)cur.pm * tstep; const char* cB = (const char*)g.Bt + (size_t)cur.pn * tstep;
    S.a_ready(cur);
    if constexpr (SP2) {
        PG8_STAGE(PG8_SB(0, 0), cB, voffB); PG8_STAGE(PG8_SB(0, 1), cB + hstep, voffB); PG8_STAGE(PG8_SA(0, 0), cA, voffA); PG8_STAGE(PG8_SA(0, 1), cA + hstep, voffA);
        if (wr == 1) PG8_BAR;
        PG8_WAIT_V(2); PG8_BAR;
        PG8_STAGE(PG8_SB(1, 0), cB + kstep, voffB); PG8_STAGE(PG8_SA(1, 0), cA + kstep, voffA); PG8_STAGE(PG8_SB(1, 1), cB + hstep + kstep, voffB);
        PG8_WAIT_V(6); PG8_BAR;
    } else {
        PG8_STAGE(PG8_SB(0, 0), cB, voffB); PG8_STAGE(PG8_SA(0, 0), cA, voffA); PG8_STAGE(PG8_SB(0, 1), cB + hstep, voffB); PG8_STAGE(PG8_SA(0, 1), cA + hstep, voffA);
        if (wr == 1) PG8_BAR;
        PG8_WAIT_V(4); PG8_BAR;
        PG8_STAGE(PG8_SB(1, 0), cB + kstep, voffB); PG8_STAGE(PG8_SA(1, 0), cA + kstep, voffA); PG8_STAGE(PG8_SB(1, 1), cB + hstep + kstep, voffB);
        PG8_WAIT_V(6); PG8_BAR;
    }
    for (;;) {
        const bool has_next = S.next(ui + 1, nxt);
        const char* nA = has_next ? (const char*)g.A + (size_t)nxt.pm * tstep : cA; const char* nB = has_next ? (const char*)g.Bt + (size_t)nxt.pn * tstep : cB;
        for (int t = 0; t < nt; t += 2) {
            const bool last = (t == nt - 2);
            const char* a1 = cA + (size_t)(t + 1) * kstep;
            const char* a2 = last ? nA : cA + (size_t)(t + 2) * kstep; const char* b2 = last ? nB : cB + (size_t)(t + 2) * kstep;
            const char* a3 = a2 + kstep; const char* b3 = b2 + kstep;
            if (last && has_next) S.a_ready(nxt);
            if constexpr (SP2) {
            PG8_LDB(B0, 0, 0); PG8_LDB(B1, 0, 1); PG8_SCHED; PG8_LDA(At, 0, 0); PG8_STAGE(PG8_SA(1, 1), a1 + hstep, voffA);
            PG8_WAIT_V(8); PG8_WAIT_L(0); PG8_BAR; PG8_MMA(0, 0, At, B0); PG8_MMA(0, 1, At, B1); PG8_BAR; PG8_SCHED;
            PG8_LDA(At, 0, 1); PG8_STAGE(PG8_SB(0, 0), b2, voffB); PG8_STAGE(PG8_SB(0, 1), b2 + hstep, voffB); PG8_STAGE(PG8_SA(0, 0), a2, voffA);
            PG8_WAIT_V(8); PG8_WAIT_L(0); PG8_BAR; PG8_MMA(1, 0, At, B0); PG8_MMA(1, 1, At, B1); PG8_BAR; PG8_SCHED;
            PG8_LDB(B0, 1, 0); PG8_LDB(B1, 1, 1); PG8_SCHED; PG8_LDA(At, 1, 0); PG8_STAGE(PG8_SA(0, 1), a2 + hstep, voffA);
            PG8_WAIT_V(8); PG8_WAIT_L(0); PG8_BAR; PG8_MMA(0, 0, At, B0); PG8_MMA(0, 1, At, B1); PG8_BAR; PG8_SCHED;
            PG8_LDA(At, 1, 1); PG8_STAGE(PG8_SB(1, 0), b3, voffB); PG8_STAGE(PG8_SB(1, 1), b3 + hstep, voffB); PG8_STAGE(PG8_SA(1, 0), a3, voffA);
            PG8_WAIT_V(8); PG8_WAIT_L(0); PG8_BAR; PG8_MMA(1, 0, At, B0); PG8_MMA(1, 1, At, B1); PG8_BAR; PG8_SCHED;
            } else {
            PG8_LDB(B0, 0, 0); PG8_SCHED; PG8_LDA(At, 0, 0); PG8_STAGE(PG8_SA(1, 1), a1 + hstep, voffA);
            PG8_WAIT_L(8); PG8_BAR; PG8_WAIT_L(0); PG8_MMA(0, 0, At, B0); PG8_BAR; PG8_SCHED;
            PG8_LDB(B1, 0, 1); PG8_STAGE(PG8_SB(0, 0), b2, voffB);
            PG8_BAR; PG8_WAIT_L(0); PG8_MMA(0, 1, At, B1); PG8_BAR;
            PG8_LDA(At, 0, 1); PG8_STAGE(PG8_SA(0, 0), a2, voffA);
            PG8_BAR; PG8_WAIT_L(0); PG8_MMA(1, 0, At, B0); PG8_BAR; PG8_SCHED;
            PG8_STAGE(PG8_SB(0, 1), b2 + hstep, voffB);
            PG8_WAIT_V(6); PG8_BAR; PG8_MMA(1, 1, At, B1); PG8_BAR;
            PG8_LDB(B0, 1, 0); PG8_SCHED; PG8_LDA(At, 1, 0); PG8_STAGE(PG8_SA(0, 1), a2 + hstep, voffA);
            PG8_WAIT_L(8); PG8_BAR; PG8_WAIT_L(0); PG8_MMA(0, 0, At, B0); PG8_BAR; PG8_SCHED;
            PG8_LDB(B1, 1, 1); PG8_STAGE(PG8_SB(1, 0), b3, voffB);
            PG8_BAR; PG8_WAIT_L(0); PG8_MMA(0, 1, At, B1); PG8_BAR;
            PG8_LDA(At, 1, 1); PG8_STAGE(PG8_SA(1, 0), a3, voffA);
            PG8_BAR; PG8_WAIT_L(0); PG8_MMA(1, 0, At, B0); PG8_BAR; PG8_SCHED;
            PG8_STAGE(PG8_SB(1, 1), b3 + hstep, voffB);
            PG8_WAIT_V(6); PG8_BAR; PG8_MMA(1, 1, At, B1); PG8_BAR;
            }
        }
        if constexpr (ALIGN_EPI) { if (wr == 0) PG8_BAR; }
        if constexpr (!Epi::AFTER_DRAIN) { E(acc, cur, wr, wc, fr, fq); S.done(cur); }
        if (!has_next) break;
#pragma unroll
        for (int a = 0; a < 2; ++a)
#pragma unroll
            for (int b = 0; b < 2; ++b)
#pragma unroll
                for (int m = 0; m < 4; ++m)
#pragma unroll
                    for (int n = 0; n < 2; ++n) acc[a][b][m][n] = (f32x4){0.f, 0.f, 0.f, 0.f};
        cur = nxt; cA = nA; cB = nB; ++ui;
        if constexpr (ALIGN_EPI) { if (wr == 1) PG8_BAR; }
    }
    PG8_WAIT_V(0);
    if constexpr (!ALIGN_EPI) { if (wr == 0) PG8_BAR; }
    PG8_BAR;
    if constexpr (Epi::AFTER_DRAIN) { E.fused(acc, cur, wr, wc, fr, fq, lds, wid, lane); S.done(cur); }
#undef PG8_SA
#undef PG8_SB
#undef PG8_STAGE
#undef PG8_LDA
#undef PG8_LDB
#undef PG8_MMA
#undef PG8_WAIT_V
#undef PG8_WAIT_L
#undef PG8_BAR
#undef PG8_SCHED
}
}

#define GAS __attribute__((address_space(1)))
#define LAS __attribute__((address_space(3)))
typedef unsigned short bf16;
typedef unsigned v4u __attribute__((ext_vector_type(4)));
typedef unsigned v2u __attribute__((ext_vector_type(2)));
typedef float f32x4 __attribute__((ext_vector_type(4)));
typedef float f32x2 __attribute__((ext_vector_type(2)));
typedef float f32x16 __attribute__((ext_vector_type(16)));
typedef short bf16x8 __attribute__((ext_vector_type(8)));
typedef short s16x4 __attribute__((ext_vector_type(4)));

#ifndef MK_N_LAUNCHES
#define MK_N_LAUNCHES 1
#endif
constexpr int NPHASE = 13;
constexpr int NWAVES = 8, NTHR = 512;

constexpr int BATCH = 8, SEQ = 2048, DM = 2048, M = BATCH * SEQ;
constexpr int HW = 1024, NH = 8, DQK = 192, DNOPE = 128, DROPE = 64, DV = 128, QLR = 512, KVLR = 256;
constexpr int INW = 3 * HW + QLR + KVLR + DROPE, INWP = 4096;
constexpr int DFF = 5632, FE = 33, FH = 64;
constexpr int NQ = NH * DQK  , NKV = NH * (DNOPE + DV)  , AW = NH * DV  ;
constexpr float EPS = 1e-6f;
constexpr int KFLEN = 4112;

constexpr size_t MiB = 1u << 20;
constexpr size_t WS_CNT = 16384, WS_CNT2 = 32768, WS_SS1 = 65536, WS_SS2 = 131072, WS_SS3 = 196608, CTL_BYTES = 262144;
constexpr size_t WS_WIN = 1 * MiB, WS_WUQ = 17 * MiB, WS_WUKV = 19 * MiB, WS_WOUT = 20 * MiB, WS_WUP = 28 * MiB, WS_WDOWN = 72 * MiB;
constexpr size_t WS_H2 = 95 * MiB;
constexpr size_t WS_ROPE = 94 * MiB;
constexpr size_t WS_XN = 96 * MiB;
constexpr size_t WS_UT = 96 * MiB, WS_X0T = 128 * MiB;
constexpr size_t WS_PROJ = 160 * MiB;
constexpr size_t WS_MIXIN = 160 * MiB, WS_O = 224 * MiB, WS_MIXED = 256 * MiB;
constexpr size_t WS_CQN = 320 * MiB, WS_CKVN = 336 * MiB, WS_KPE = 344 * MiB, WS_KF = 346 * MiB;
constexpr size_t WS_Q = 356 * MiB, WS_KV = 404 * MiB;
constexpr size_t WS_YT = 468 * MiB;
constexpr size_t WS_ACT = 160 * MiB;
constexpr size_t WS_BB = 336 * MiB;
constexpr size_t WS_F = 96 * MiB;
constexpr size_t WS_H16 = 436 * MiB;
constexpr size_t WS_END = 500 * MiB;

constexpr int LDS_BYTES = 147456;

__device__ __forceinline__ unsigned f2bf(float f) { unsigned u = __builtin_bit_cast(unsigned, f); return (u + 0x7fffu + ((u >> 16) & 1u)) >> 16; }
__device__ __forceinline__ unsigned pk2(float lo, float hi) { return f2bf(lo) | (f2bf(hi) << 16); }
__device__ __forceinline__ float bflo(unsigned w) { return __builtin_bit_cast(float, w << 16); }
__device__ __forceinline__ float bfhi(unsigned w) { return __builtin_bit_cast(float, w & 0xffff0000u); }
__device__ __forceinline__ float bf1(bf16 h) { return __builtin_bit_cast(float, (unsigned)h << 16); }
#define LDS_WAIT() asm volatile("s_waitcnt lgkmcnt(0)" ::: "memory")
__device__ __forceinline__ float wave_sum(float v) {
#pragma unroll
    for (int o = 1; o < 64; o <<= 1) v += __shfl_xor(v, o);
    return v;
}
__device__ __forceinline__ void sincos_acc(float x, float& s, float& c) {
    const double xd = (double)x; const double k = rint(xd * 0.6366197723675814);
    const float y = (float)(xd - k * 1.5707963267948966); const int q = ((int)k) & 3;
    const float y2 = y * y;
    const float sp = y + y * y2 * (-1.6666654611e-1f + y2 * (8.3321608736e-3f + y2 * (-1.9515295891e-4f)));
    const float cp = 1.f - 0.5f * y2 + y2 * y2 * (4.166664568298827e-2f + y2 * (-1.388731625493765e-3f + y2 * 2.443315711809948e-5f));
    const float s0 = (q & 1) ? cp : sp, c0 = (q & 1) ? sp : cp;
    s = (q & 2) ? -s0 : s0; c = ((q + 1) & 2) ? -c0 : c0;
}

#define XB_TMO      128
#define XB_XCNT(j)  (256  + 64 * (j))
#define XB_XSUB(j)  (1280 + 64 * (j))
#define XB_XGEN(j)  (2304 + 64 * (j))
#define XB_TOP      3328
#define XB_TOPGEN   3392
#define XCD_BAR_WORDS 3456
#define XB_SPIN_CAP (1u << 18)

__device__ __forceinline__ unsigned xb_ld(unsigned* p)              { return __hip_atomic_load(p, __ATOMIC_RELAXED, __HIP_MEMORY_SCOPE_AGENT); }
__device__ __forceinline__ unsigned xb_add(unsigned* p, unsigned v) { return __hip_atomic_fetch_add(p, v, __ATOMIC_RELAXED, __HIP_MEMORY_SCOPE_AGENT); }
__device__ __forceinline__ unsigned xb_xcc_id() { return (unsigned)__builtin_amdgcn_s_getreg((3 << 11) | 20) & 0xFu; }
#define XB_SPIN(cond, bar) do { unsigned _sp = 0; while (cond) { __builtin_amdgcn_s_sleep(1); \
    if ((++_sp & 255u) == 0u) { if (xb_ld(&(bar)[XB_TMO])) break; if (_sp > XB_SPIN_CAP) { atomicAdd(&(bar)[XB_TMO], 1u); break; } } } } while (0)

struct XcdBarrier {
    unsigned* bar; unsigned x;
    volatile LAS unsigned* st;
};

__device__ __forceinline__ XcdBarrier xcd_barrier_post(unsigned* bar, volatile LAS unsigned* st) {
    XcdBarrier b; b.bar = bar; b.x = xb_xcc_id(); b.st = st;
    if (threadIdx.x == 0) (void)xb_add(&bar[XB_XCNT(b.x)], 1u);
    return b;
}
__device__ __forceinline__ void xcd_barrier_complete(unsigned* bar, unsigned x, unsigned& nloc, unsigned& nx) {
    const unsigned G = gridDim.x * gridDim.y * gridDim.z;
    unsigned sum, cnt, mine, sp = 0u;
    for (;;) {
        sum = 0u; cnt = 0u; mine = 0u;
#pragma unroll
        for (unsigned j = 0; j < 16; ++j) { const unsigned c = xb_ld(&bar[XB_XCNT(j)]); sum += c; cnt += (c > 0u) ? 1u : 0u; mine = (j == x) ? c : mine; }
        if (sum == G) break;
        __builtin_amdgcn_s_sleep(1);
        if ((++sp & 255u) == 0u) { if (xb_ld(&bar[XB_TMO])) break; if (sp > XB_SPIN_CAP) { atomicAdd(&bar[XB_TMO], 1u); break; } }
    }
    nloc = mine > 0u ? mine : 1u; nx = cnt > 0u ? cnt : 1u;
}

__device__ __forceinline__ void xcd_barrier(const XcdBarrier& b) {
    asm volatile("s_waitcnt vmcnt(0)" ::: "memory");
    __syncthreads();
    if (threadIdx.x == 0) {
        unsigned* bar = b.bar;
        __builtin_amdgcn_s_waitcnt(0);
        unsigned nloc = b.st[0], nx = b.st[1];
        if (nloc == 0u) { xcd_barrier_complete(bar, b.x, nloc, nx); b.st[0] = nloc; b.st[1] = nx; }
        const unsigned old = xb_add(&bar[XB_XSUB(b.x)], 1u);
        const unsigned gen = old / nloc;
        if (old + 1u == (gen + 1u) * nloc) {
            __builtin_amdgcn_fence(__ATOMIC_RELEASE, "agent");
            asm volatile("s_waitcnt vmcnt(0)" ::: "memory");
            const unsigned og = xb_add(&bar[XB_TOP], 1u);
            const unsigned tg = og / nx;
            if (og + 1u == (tg + 1u) * nx) xb_add(&bar[XB_TOPGEN], 1u);
            else XB_SPIN(xb_ld(&bar[XB_TOPGEN]) == tg, bar);
            __builtin_amdgcn_fence(__ATOMIC_ACQUIRE, "agent");
            xb_add(&bar[XB_XGEN(b.x)], 1u);
            asm volatile("s_waitcnt vmcnt(0)" ::: "memory");
        } else {
            XB_SPIN(xb_ld(&bar[XB_XGEN(b.x)]) == gen, bar);
            __builtin_amdgcn_fence(__ATOMIC_ACQUIRE, "agent");
            asm volatile("s_waitcnt vmcnt(0)" ::: "memory");
        }
    }
    __syncthreads();
}

struct Frame {
    LAS unsigned char* lds; char* ldsg;
    int tid, lane, wave, vcu, G;
    const float* in[27]; float* out; unsigned char* ws;
};

__device__ __forceinline__ void p0_transpose_item(const float* W, int K, int N, bf16* WT, int k0, int n0, int drow0, LAS float* scr, int lane, const float* kscale) {
    f32x4 v[8];
#pragma unroll
    for (int i = 0; i < 8; ++i) v[i] = __builtin_nontemporal_load((const f32x4*)(W + (size_t)(k0 + (lane >> 3) + 8 * i) * N + n0 + (lane & 7) * 4));
#pragma unroll
    for (int i = 0; i < 8; ++i) { LAS float* d = scr + ((lane >> 3) + 8 * i) * 33 + (lane & 7) * 4; d[0] = v[i].x; d[1] = v[i].y; d[2] = v[i].z; d[3] = v[i].w; }
    LDS_WAIT(); asm volatile("" ::: "memory");
    const int c = lane & 7;
    float ks[8];
#pragma unroll
    for (int e = 0; e < 8; ++e) ks[e] = kscale ? kscale[k0 + 8 * c + e] : 1.f;
#pragma unroll
    for (int j = 0; j < 4; ++j) { const int n = (lane >> 3) + 8 * j; const LAS float* s = scr + (8 * c) * 33 + n;
        v4u o; o.x = pk2(s[0 * 33] * ks[0], s[1 * 33] * ks[1]); o.y = pk2(s[2 * 33] * ks[2], s[3 * 33] * ks[3]); o.z = pk2(s[4 * 33] * ks[4], s[5 * 33] * ks[5]); o.w = pk2(s[6 * 33] * ks[6], s[7 * 33] * ks[7]);
        if (kscale || K == DFF || N == DM) __builtin_nontemporal_store(o, (v4u*)(WT + (size_t)(drow0 + n) * K + k0 + 8 * c));
        else *(GAS v4u*)(WT + (size_t)(drow0 + n) * K + k0 + 8 * c) = o; }
    LDS_WAIT(); asm volatile("" ::: "memory");
}
__device__ __forceinline__ void p0_transpose_mat(Frame& F, const float* W, int K, int N, bf16* WT, bool upmap, const float* kscale = nullptr) {
    LAS float* scr = (LAS float*)(F.lds + F.wave * 16384);
    const int gw = F.vcu * NWAVES + F.wave, NGW = F.G * NWAVES; const int nblk = N / 32, nitems = (K / 64) * nblk;
    for (int it = gw; it < nitems; it += NGW) { const int kb = it / nblk, nb = it % nblk, n0 = 32 * nb;
        int drow0 = n0;
        if (upmap) drow0 = (n0 < DFF) ? (n0 >> 7) * 256 + (n0 & 127) : ((n0 - DFF) >> 7) * 256 + 128 + ((n0 - DFF) & 127);
        p0_transpose_item(W, K, N, WT, 64 * kb, n0, drow0, scr, F.lane, kscale); }
}
__device__ __forceinline__ void rms_row_to_bf16(const float* xrow, const float* gain, bf16* orow, int lane) {
    f32x4 v[8]; float s = 0.f;
#pragma unroll
    for (int j = 0; j < 8; ++j) { v[j] = __builtin_nontemporal_load((const f32x4*)(xrow + 4 * (lane + 64 * j))); s += (v[j].x * v[j].x + v[j].y * v[j].y) + (v[j].z * v[j].z + v[j].w * v[j].w); }
    const float r = 1.f / sqrtf(wave_sum(s) * (1.f / DM) + EPS);
#pragma unroll
    for (int j = 0; j < 8; ++j) { const f32x4 g = *(const f32x4*)(gain + 4 * (lane + 64 * j));
        v2u o; o.x = pk2(v[j].x * r * g.x, v[j].y * r * g.y); o.y = pk2(v[j].z * r * g.z, v[j].w * r * g.w);
        *(v2u*)(orow + 4 * (lane + 64 * j)) = o; }
}
__device__ __forceinline__ void p0_filter_hidden(Frame& F) {
    LAS float* Z = (LAS float*)F.lds;
    LAS float* H1 = Z + 8 * 33;
    const float *w1 = F.in[5], *b1 = F.in[6], *fr1 = F.in[7], *w2 = F.in[8], *b2 = F.in[9], *fr2 = F.in[10];
    float* H2G = (float*)(F.ws + WS_H2);
    const int tid = F.tid;
    for (int unit = F.vcu; unit < SEQ / 8; unit += F.G) {
        const int l0 = unit * 8;
        __syncthreads();
        if (tid < 8 * 33) { const int l = l0 + tid / 33, f = tid % 33; float v;
            if (f == 0) v = (float)l * (1.0f / (float)(SEQ - 1));
            else { const int j = (f - 1) & 15; const float w = 6.283185307179586f * (float)l / (float)SEQ; const float fj = 1e-4f + (float)j * ((15.0f - 1e-4f) / 15.0f);
                float s, c; sincos_acc(w * fj, s, c); v = (f <= 16) ? c : -s; }
            Z[tid] = v; }
        __syncthreads();
        const int l = tid >> 6, k = tid & 63;
        { float a = b1[k];
#pragma unroll
          for (int f = 0; f < FE; ++f) a += Z[l * 33 + f] * w1[f * FH + k];
          float s, c; sincos_acc(fr1[k] * a, s, c); H1[l * 65 + k] = s; }
        __syncthreads();
        { float a = b2[k];
#pragma unroll 16
          for (int j = 0; j < FH; ++j) a += H1[l * 65 + j] * w2[j * FH + k];
          float s, c; sincos_acc(fr2[k] * a, s, c); H2G[(size_t)(l0 + l) * FH + k] = s; }
    }
    __syncthreads();
}
__device__ __forceinline__ void p2_filter_out(Frame& F) {
    LAS float* H2 = (LAS float*)F.lds;
    LAS float* W3 = H2 + 64 * 65 + 12;
    const float* w3 = F.in[11]; const float* H2G = (const float*)(F.ws + WS_H2);
    bf16* KF = (bf16*)(F.ws + WS_KF);
    const int tid = F.tid;
    for (int i = F.vcu * NTHR + tid; i < HW * 17; i += F.G * NTHR) KF[(size_t)(i / 17) * KFLEN + (i % 17)] = 0;
    for (int unit = F.vcu; unit < 32 * 16; unit += F.G) {
        const int l0 = (unit >> 4) * 64, n0 = (unit & 15) * 128;
        __syncthreads();
#pragma unroll
        for (int i = 0; i < 2; ++i) { const int id = tid + NTHR * i; const int l = id >> 4, k4 = (id & 15) * 4; const f32x4 v = *(const f32x4*)(H2G + (size_t)(l0 + l) * FH + k4);
            LAS float* d = H2 + l * 65 + k4; d[0] = v.x; d[1] = v.y; d[2] = v.z; d[3] = v.w; }
#pragma unroll
        for (int i = 0; i < 4; ++i) { const int id = tid + NTHR * i; const int k = id >> 5, c4 = (id & 31) * 4;
            *(LAS f32x4*)(W3 + k * 128 + c4) = *(const f32x4*)(w3 + (size_t)k * (2 * HW) + n0 + c4); }
        __syncthreads();
        { const int l = tid & 63, ng = __builtin_amdgcn_readfirstlane(tid >> 6); const int nb = n0 + ng * 16;
          float acc[16];
#pragma unroll
          for (int i = 0; i < 16; ++i) acc[i] = 0.f;
#pragma unroll 4
          for (int k = 0; k < FH; ++k) { const float h = H2[l * 65 + k]; const LAS f32x4* wr = (const LAS f32x4*)(W3 + k * 128 + ng * 16);
#pragma unroll
              for (int q = 0; q < 4; ++q) { const f32x4 wv = wr[q]; acc[4 * q] += h * wv.x; acc[4 * q + 1] += h * wv.y; acc[4 * q + 2] += h * wv.z; acc[4 * q + 3] += h * wv.w; } }
          const int lg = l0 + l; const float tl = (float)lg * (1.0f / (float)(SEQ - 1));
          const float mind = -3.0701134573253945f, maxd = -15.350567286626973f;
#pragma unroll
          for (int i = 0; i < 16; ++i) { const int n = nb + i, dir = n >> 10, c = n & 1023;
              const float delta = fabsf(mind + (float)c * ((maxd - mind) / 1023.0f));
              const float win = __expf(-tl * delta) + 0.05f; const float v = acc[i] * win;
              if (dir == 0) KF[(size_t)c * KFLEN + 16 + 2048 - lg] = (bf16)f2bf(v);
              else if (lg > 0) KF[(size_t)c * KFLEN + 16 + 2048 + lg] = (bf16)f2bf(v); }
        }
    }
    __syncthreads();
}
__device__ __forceinline__ void p0_prologue(Frame& F) {
    unsigned char* ws = F.ws;
    p0_transpose_mat(F, F.in[2], DM, INW, (bf16*)(ws + WS_WIN), false);
    p0_transpose_mat(F, F.in[14], QLR, NQ, (bf16*)(ws + WS_WUQ), false);
    p0_transpose_mat(F, F.in[16], KVLR, NKV, (bf16*)(ws + WS_WUKV), false);
    p0_transpose_mat(F, F.in[19], DM, DM, (bf16*)(ws + WS_WOUT), false);
    p0_transpose_mat(F, F.in[22], DM, 2 * DFF, (bf16*)(ws + WS_WUP), true, F.in[21]);
    p0_transpose_mat(F, F.in[25], DFF, DM, (bf16*)(ws + WS_WDOWN), false);
    const int gw = F.vcu * NWAVES + F.wave, NGW = F.G * NWAVES;
    bf16* XN = (bf16*)(ws + WS_XN);
    for (int m = gw; m < M; m += NGW) rms_row_to_bf16(F.in[0] + (size_t)m * DM, F.in[1], XN + (size_t)m * DM, F.lane);
}
__device__ __forceinline__ void p0_pre(Frame& F) {
    f32x2* ROPE = (f32x2*)(F.ws + WS_ROPE);
    for (int i = F.vcu * NTHR + F.tid; i < SEQ * 32; i += F.G * NTHR) { const int s = i >> 5, j = i & 31;
        const float invf = 1.0f / powf(10000.0f, (float)(2 * j) / 64.0f); const float ang = (float)s * invf;
        float sn, cs; sincos_acc(ang, sn, cs); ROPE[i] = (f32x2){cs, sn}; }
    p0_filter_hidden(F);
}

__device__ __forceinline__ void p2_hyena_prep(Frame& F) {
    constexpr int TP = 72;
    LAS bf16* TB = (LAS bf16*)F.lds;
    const bf16* PROJ = (const bf16*)(F.ws + WS_PROJ); bf16* UT = (bf16*)(F.ws + WS_UT); bf16* X0T = (bf16*)(F.ws + WS_X0T);
    const float* cw = F.in[3]; const float* cb = F.in[4];
    const int tid = F.tid, ch = tid & 7, sl = tid >> 3;
    int it = 0;
    for (int unit = F.vcu; unit < BATCH * 32 * 16; unit += F.G, ++it) {
        const int ct = unit & 15, st = (unit >> 4) & 31, b = unit >> 9; const int c0 = ct * 64 + ch * 8, s = st * 64 + sl;
        v4u w[3][3];
#pragma unroll
        for (int a = 0; a < 3; ++a)
#pragma unroll
            for (int j = 0; j < 3; ++j) { const int ss = s - 1 + j; w[a][j] = (v4u){0u, 0u, 0u, 0u};
                if (ss >= 0 && ss < SEQ) w[a][j] = *(const v4u*)(PROJ + (size_t)(b * SEQ + ss) * INWP + a * HW + c0); }
        float val[3][8];
#pragma unroll
        for (int a = 0; a < 3; ++a) { const float* wp = cw + a * HW + c0;
            const f32x4 k0a = *(const f32x4*)(wp), k0b = *(const f32x4*)(wp + 4), k1a = *(const f32x4*)(wp + 3 * HW), k1b = *(const f32x4*)(wp + 3 * HW + 4);
            const f32x4 k2a = *(const f32x4*)(wp + 6 * HW), k2b = *(const f32x4*)(wp + 6 * HW + 4), bba = *(const f32x4*)(cb + a * HW + c0), bbb = *(const f32x4*)(cb + a * HW + c0 + 4);
            const float k0[8] = {k0a.x, k0a.y, k0a.z, k0a.w, k0b.x, k0b.y, k0b.z, k0b.w}, k1[8] = {k1a.x, k1a.y, k1a.z, k1a.w, k1b.x, k1b.y, k1b.z, k1b.w};
            const float k2[8] = {k2a.x, k2a.y, k2a.z, k2a.w, k2b.x, k2b.y, k2b.z, k2b.w}, bb[8] = {bba.x, bba.y, bba.z, bba.w, bbb.x, bbb.y, bbb.z, bbb.w};
            const unsigned r0[4] = {w[a][0].x, w[a][0].y, w[a][0].z, w[a][0].w}, r1[4] = {w[a][1].x, w[a][1].y, w[a][1].z, w[a][1].w}, r2[4] = {w[a][2].x, w[a][2].y, w[a][2].z, w[a][2].w};
#pragma unroll
            for (int k = 0; k < 4; ++k) {
                val[a][2 * k] = k0[2 * k] * bflo(r0[k]) + k1[2 * k] * bflo(r1[k]) + k2[2 * k] * bflo(r2[k]) + bb[2 * k];
                val[a][2 * k + 1] = k0[2 * k + 1] * bfhi(r0[k]) + k1[2 * k + 1] * bfhi(r1[k]) + k2[2 * k + 1] * bfhi(r2[k]) + bb[2 * k + 1]; } }
        LAS bf16* Tu = TB + (it & 1) * (2 * 64 * TP); LAS bf16* Tx = Tu + 64 * TP;
#pragma unroll
        for (int e = 0; e < 8; ++e) { Tu[(ch * 8 + e) * TP + sl] = (bf16)f2bf(val[1][e] * val[2][e]); Tx[(ch * 8 + e) * TP + sl] = (bf16)f2bf(val[0][e]); }
        __syncthreads();
        { const int c = tid >> 3, pc = tid & 7; const size_t o = ((size_t)(ct * 64 + c) * BATCH + b) * SEQ + st * 64 + pc * 8;
          *(v4u*)(UT + o) = *(const LAS v4u*)(Tu + c * TP + pc * 8); *(v4u*)(X0T + o) = *(const LAS v4u*)(Tx + c * TP + pc * 8); }
    }
    __syncthreads();
}
__device__ __forceinline__ void p2_mla_prep(Frame& F) {
    const bf16* PROJ = (const bf16*)(F.ws + WS_PROJ); bf16* CQN = (bf16*)(F.ws + WS_CQN); bf16* CKVN = (bf16*)(F.ws + WS_CKVN); bf16* KPE = (bf16*)(F.ws + WS_KPE);
    const f32x2* ROPE = (const f32x2*)(F.ws + WS_ROPE);
    const float* gq = F.in[13]; const float* gkv = F.in[15];
    const int gw = F.vcu * NWAVES + F.wave, NGW = F.G * NWAVES, lane = F.lane;
    const f32x4 gq0 = *(const f32x4*)(gq + 8 * lane), gq1 = *(const f32x4*)(gq + 8 * lane + 4), gk0 = *(const f32x4*)(gkv + 4 * lane);
    constexpr int UR = 2;
    for (int m0 = gw; m0 < M; m0 += NGW * UR) {
        v4u wq[UR]; v2u wk[UR]; bf16 xp[UR]; f32x2 cs[UR];
#pragma unroll
        for (int u = 0; u < UR; ++u) { const int m = m0 + u * NGW; const bf16* row = PROJ + (size_t)m * INWP;
            wq[u] = __builtin_nontemporal_load((const v4u*)(row + 3 * HW + 8 * lane)); wk[u] = __builtin_nontemporal_load((const v2u*)(row + 3 * HW + QLR + 4 * lane));
            xp[u] = row[3 * HW + QLR + KVLR + lane]; cs[u] = ROPE[(m & (SEQ - 1)) * 32 + (lane & 31)]; }
#pragma unroll
        for (int u = 0; u < UR; ++u) { const int m = m0 + u * NGW;
            { const v4u w = wq[u];
              float v[8] = {bflo(w.x), bfhi(w.x), bflo(w.y), bfhi(w.y), bflo(w.z), bfhi(w.z), bflo(w.w), bfhi(w.w)}; float s = 0.f;
#pragma unroll
              for (int i = 0; i < 8; ++i) s += v[i] * v[i];
              const float r = 1.f / sqrtf(wave_sum(s) * (1.f / QLR) + EPS);
              v4u o; o.x = pk2(v[0] * r * gq0.x, v[1] * r * gq0.y); o.y = pk2(v[2] * r * gq0.z, v[3] * r * gq0.w); o.z = pk2(v[4] * r * gq1.x, v[5] * r * gq1.y); o.w = pk2(v[6] * r * gq1.z, v[7] * r * gq1.w);
              *(v4u*)(CQN + (size_t)m * QLR + 8 * lane) = o; }
            { const v2u w = wk[u];
              float v[4] = {bflo(w.x), bfhi(w.x), bflo(w.y), bfhi(w.y)}; float s = (v[0] * v[0] + v[1] * v[1]) + (v[2] * v[2] + v[3] * v[3]);
              const float r = 1.f / sqrtf(wave_sum(s) * (1.f / KVLR) + EPS);
              v2u o; o.x = pk2(v[0] * r * gk0.x, v[1] * r * gk0.y); o.y = pk2(v[2] * r * gk0.z, v[3] * r * gk0.w);
              *(v2u*)(CKVN + (size_t)m * KVLR + 4 * lane) = o; }
            { const float x = bf1(xp[u]); const float p = __shfl_xor(x, 32);
              const float o = x * cs[u].x + ((lane < 32) ? -p : p) * cs[u].y;
              KPE[(size_t)m * DROPE + lane] = (bf16)f2bf(o); } }
    }
}

constexpr int US_PITCH = 2120;
constexpr int KFP = 4120;
__device__ __forceinline__ bf16x8 hy_afrag(const LAS bf16* FC, int a, int i, int quad) {
    const int sh = i & 7;
    return *(const LAS bf16x8*)(FC + sh * KFP + (16 + 2048 - 32 * a + quad * 8 - (i - sh)));
}
__device__ __forceinline__ void p4_longconv(Frame& F) {
    LAS bf16* FL = (LAS bf16*)F.lds;
    LAS bf16* US = (LAS bf16*)(F.lds + 66048);
    const bf16* KF = (const bf16*)(F.ws + WS_KF); const bf16* UT = (const bf16*)(F.ws + WS_UT); const bf16* X0T = (const bf16*)(F.ws + WS_X0T); bf16* YT = (bf16*)(F.ws + WS_YT);
    const float* hbias = F.in[12];
    const int tid = F.tid, lane = F.lane, w = F.wave, i16 = lane & 15, quad = lane >> 4, batch = lane & 7, g = (lane >> 3) & 1;
    for (int c = F.vcu; c < HW; c += F.G) {
        __syncthreads();
        { v4u kf[9], us[4];
#pragma unroll
          for (int i = 0; i < 9; ++i) { const int id = tid + NTHR * i; const int sh = id & 7, ck = (id >> 3) + 1;
              kf[i] = (v4u){0u, 0u, 0u, 0u}; if (id < 8 * 513) __builtin_memcpy(&kf[i], (const char*)(KF + (size_t)c * KFLEN + ck * 8 - sh), 16); }
#pragma unroll
          for (int i = 0; i < 4; ++i) { const int id = tid + NTHR * i; const int b = id >> 8, ch = id & 255;
              us[i] = __builtin_nontemporal_load((const v4u*)(UT + ((size_t)c * BATCH + b) * SEQ + ch * 8)); }
#pragma unroll
          for (int i = 0; i < 9; ++i) { const int id = tid + NTHR * i; const int sh = id & 7, ck = (id >> 3) + 1; if (id < 8 * 513) *(LAS v4u*)(FL + sh * KFP + ck * 8) = kf[i]; }
#pragma unroll
          for (int i = 0; i < 4; ++i) { const int id = tid + NTHR * i; const int b = id >> 8, ch = id & 255; *(LAS v4u*)(US + b * US_PITCH + 32 + ch * 8) = us[i]; } }
        for (int id = tid; id < 8 * 9; id += NTHR) { const int b = id / 9, ch = id % 9;
            const int off = (ch < 4) ? ch * 8 : 32 + 2048 + (ch - 4) * 8; *(LAS v4u*)(US + b * US_PITCH + off) = (v4u){0u, 0u, 0u, 0u}; }
        __syncthreads();
        f32x4 acc[8]; bf16x8 ar[8];
#pragma unroll
        for (int p = 0; p < 8; ++p) acc[p] = (f32x4){0.f, 0.f, 0.f, 0.f};
#pragma unroll
        for (int p = 0; p < 8; ++p) ar[p] = hy_afrag(FL, 8 * w + p + 1, i16, quad);
        const LAS bf16* ub = US + batch * US_PITCH + 32 + 16 * g + quad * 8;
        bf16x8 bcur = *(const LAS bf16x8*)(ub - 32);
        for (int J = 0; J < 9; ++J) {
#pragma unroll
            for (int jj8 = 0; jj8 < 8; ++jj8) {
                const int jj = J * 8 + jj8;
                if (jj < 65) {
                    const int j = jj - 1; const bool more = (jj + 1 < 65);
                    bf16x8 bnext = bcur, anext = ar[(7 - jj8) & 7];
                    if (more) { bnext = *(const LAS bf16x8*)(ub + 32 * (j + 1)); anext = hy_afrag(FL, 8 * w - (j + 1), i16, quad); }
#pragma unroll
                    for (int p = 0; p < 8; ++p) acc[p] = __builtin_amdgcn_mfma_f32_16x16x32_bf16(ar[(p - jj8) & 7], bcur, acc[p], 0, 0, 0);
                    ar[(7 - jj8) & 7] = anext; bcur = bnext;
                }
            }
        }
        const float hb = hbias[c];
#pragma unroll
        for (int p = 0; p < 8; ++p) { const int t = 32 * (8 * w + p) + 16 * g + quad * 4;
            const size_t o = ((size_t)c * BATCH + batch) * SEQ + t;
            const v2u xw = __builtin_nontemporal_load((const v2u*)(X0T + o)); const v2u uw = *(const LAS v2u*)(US + batch * US_PITCH + 32 + t);
            const float y0 = bflo(xw.x) * (acc[p][0] + hb * bflo(uw.x)), y1 = bfhi(xw.x) * (acc[p][1] + hb * bfhi(uw.x));
            const float y2 = bflo(xw.y) * (acc[p][2] + hb * bflo(uw.y)), y3 = bfhi(xw.y) * (acc[p][3] + hb * bfhi(uw.y));
            v2u ov; ov.x = pk2(y0, y1); ov.y = pk2(y2, y3); *(v2u*)(YT + o) = ov; }
    }
    __syncthreads();
}

namespace att {
constexpr int QBLK = 32, KVBLK = 64;
constexpr float SCALE = 0.07216878364870322f;
constexpr float THR = 8.f;
constexpr int SHM_V = KVBLK * DV * 2  , SHM_K = KVBLK * DQK * 2  , SHM_ATTN = 2 * SHM_V + 2 * SHM_K + NWAVES * 64 * 4;
#define KSWZ(row, colB) ((row) * 384 + ((colB) ^ ((((row) >> 1) & 7) << 4)))
#define SBAR() __builtin_amdgcn_sched_barrier(0)
__device__ __forceinline__ int crow(int r, int hi) { return (r & 3) + 8 * (r >> 2) + 4 * hi; }
__device__ __forceinline__ unsigned cvtpk(float lo, float hi) { unsigned r; asm volatile("v_cvt_pk_bf16_f32 %0, %1, %2" : "=v"(r) : "v"(lo), "v"(hi)); return r; }
__device__ __forceinline__ void partialSM(f32x16& p0, f32x16& p1, float& m_reg, float& mn, float& alpha) {
  constexpr float C = SCALE * 1.4426950408889634f;
  float pmax = p0[0];
#pragma unroll
  for (int r = 1; r < 16; ++r) pmax = fmaxf(pmax, p0[r]);
#pragma unroll
  for (int r = 0; r < 16; ++r) pmax = fmaxf(pmax, p1[r]);
  { auto rr = __builtin_amdgcn_permlane32_swap(__float_as_uint(pmax), __float_as_uint(pmax), false, false);
    pmax = fmaxf(__uint_as_float(rr[0]), __uint_as_float(rr[1])); }
  if (__builtin_expect(__all(pmax - m_reg <= THR / SCALE), 1)) { mn = m_reg; alpha = 1.f; }
  else { mn = fmaxf(m_reg, pmax); alpha = __builtin_amdgcn_exp2f((m_reg - mn) * C); m_reg = mn; }
  float mnC = -mn * C;
#pragma unroll
  for (int r = 0; r < 16; ++r) p0[r] = fmaf(p0[r], C, mnC);
#pragma unroll
  for (int r = 0; r < 16; ++r) p1[r] = fmaf(p1[r], C, mnC);
#pragma unroll
  for (int r = 0; r < 16; ++r) p0[r] = __builtin_amdgcn_exp2f(p0[r]);
}
__device__ __forceinline__ void finishSM(f32x16& p0, f32x16& p1, float alpha, float& l_reg, bf16x8& pa0, bf16x8& pa1, bf16x8& pa2, bf16x8& pa3) {
#pragma unroll
  for (int r = 0; r < 16; ++r) p1[r] = __builtin_amdgcn_exp2f(p1[r]);
  float ps = 0;
#pragma unroll
  for (int r = 0; r < 16; ++r) ps += p0[r];
#pragma unroll
  for (int r = 0; r < 16; ++r) ps += p1[r];
  { auto rr = __builtin_amdgcn_permlane32_swap(__float_as_uint(ps), __float_as_uint(ps), false, false);
    ps = __uint_as_float(rr[0]) + __uint_as_float(rr[1]); }
  l_reg = l_reg * alpha + ps;
#define PK4(P, BASE, OUT) do { unsigned a0 = cvtpk(P[BASE + 0], P[BASE + 1]), a1 = cvtpk(P[BASE + 2], P[BASE + 3]);   \
    unsigned b0 = cvtpk(P[BASE + 4], P[BASE + 5]), b1 = cvtpk(P[BASE + 6], P[BASE + 7]);                              \
    auto r0 = __builtin_amdgcn_permlane32_swap(a0, b0, false, false); auto r1 = __builtin_amdgcn_permlane32_swap(a1, b1, false, false); \
    v4u w = {r0[0], r1[0], r0[1], r1[1]}; OUT = __builtin_bit_cast(bf16x8, w); } while (0)
  PK4(p0, 0, pa0); PK4(p0, 8, pa1); PK4(p1, 0, pa2); PK4(p1, 8, pa3);
#undef PK4
}
__device__ __forceinline__ void qkt(f32x16& p0, f32x16& p1, const char* Ks, const bf16x8* qr, int r32, int hi) {
  p0 = f32x16{}; p1 = f32x16{};
#pragma unroll
  for (int d0 = 0; d0 < 12; ++d0) { int cb = (d0 * 16 + hi * 8) * 2;
    bf16x8 b0 = *reinterpret_cast<const bf16x8*>(Ks + KSWZ(r32, cb));
    bf16x8 b1 = *reinterpret_cast<const bf16x8*>(Ks + KSWZ(32 + r32, cb));
    p0 = __builtin_amdgcn_mfma_f32_32x32x16_bf16(b0, qr[d0], p0, 0, 0, 0);
    p1 = __builtin_amdgcn_mfma_f32_32x32x16_bf16(b1, qr[d0], p1, 0, 0, 0); }
}
__device__ __forceinline__ int v_st(int k, int c) { const int kk = (k & ~0xC) | ((k & 4) << 1) | ((k & 8) >> 1); return ((kk >> 3) * 4 + (c >> 5)) * 512 + ((kk & 7) * 32 + (c & 31)) * 2; }
__device__ __forceinline__ int v_rd_base(int lane) { return ((lane & 3) << 3) | (((lane >> 2) & 3) << 6) | (((lane >> 4) & 1) << 5) | (((lane >> 5) & 1) << 8); }
constexpr int v_rd_off(int d0, int ks, int half) { return d0 * 512 + ks * 4096 + half * 2048; }
template <int OFF> __device__ __forceinline__ s16x4 tr_read(int vb) {
  s16x4 r; asm volatile("ds_read_b64_tr_b16 %0, %1 offset:%2" : "=&v"(r) : "v"(vb), "i"(OFF) : "memory"); return r;
}
template <int D0> __device__ __forceinline__ void pv_one(f32x16& od, int vb, bf16x8 pa0, bf16x8 pa1, bf16x8 pa2, bf16x8 pa3) {
  const s16x4 l0 = tr_read<v_rd_off(D0, 0, 0)>(vb), h0 = tr_read<v_rd_off(D0, 0, 1)>(vb), l1 = tr_read<v_rd_off(D0, 1, 0)>(vb), h1 = tr_read<v_rd_off(D0, 1, 1)>(vb);
  const s16x4 l2 = tr_read<v_rd_off(D0, 2, 0)>(vb), h2 = tr_read<v_rd_off(D0, 2, 1)>(vb), l3 = tr_read<v_rd_off(D0, 3, 0)>(vb), h3 = tr_read<v_rd_off(D0, 3, 1)>(vb);
  asm volatile("s_waitcnt lgkmcnt(0)" ::: "memory"); SBAR();
#define PK(L, H) (bf16x8){L[0], L[1], L[2], L[3], H[0], H[1], H[2], H[3]}
  od = __builtin_amdgcn_mfma_f32_32x32x16_bf16(pa0, PK(l0, h0), od, 0, 0, 0);
  od = __builtin_amdgcn_mfma_f32_32x32x16_bf16(pa1, PK(l1, h1), od, 0, 0, 0);
  od = __builtin_amdgcn_mfma_f32_32x32x16_bf16(pa2, PK(l2, h2), od, 0, 0, 0);
  od = __builtin_amdgcn_mfma_f32_32x32x16_bf16(pa3, PK(l3, h3), od, 0, 0, 0);
#undef PK
}
__device__ __forceinline__ void pv_d0(f32x16* o, int vb, bf16x8 pa0, bf16x8 pa1, bf16x8 pa2, bf16x8 pa3) {
  pv_one<0>(o[0], vb, pa0, pa1, pa2, pa3); pv_one<1>(o[1], vb, pa0, pa1, pa2, pa3); pv_one<2>(o[2], vb, pa0, pa1, pa2, pa3); pv_one<3>(o[3], vb, pa0, pa1, pa2, pa3);
}
__device__ __forceinline__ void attn_unit(const bf16* __restrict__ Qb, const bf16* __restrict__ KVh, const bf16* __restrict__ KPb, bf16* __restrict__ Ob, const f32x2* __restrict__ rope, char* lds) {
  const int tid = threadIdx.x, wid = tid >> 6, lane = tid & 63, r32 = lane & 31, hi = lane >> 5;
  char* V_lds = lds; char* K_lds = lds + 2 * SHM_V;
  float* wsf = (float*)(lds + 2 * SHM_V + 2 * SHM_K) + wid * 64; float* li_l = wsf; float* al_l = wsf + 32;
  float m_reg = -1e30f, l_reg = 0; f32x16 o[4] = {}; bf16x8 qr[12];
  { const bf16* Qw = Qb + (size_t)(wid * QBLK + r32) * NQ + hi * 8;
#pragma unroll
    for (int d0 = 0; d0 < 8; ++d0) qr[d0] = *reinterpret_cast<const bf16x8*>(Qw + d0 * 16);
    const f32x2* rp = rope + (size_t)(wid * QBLK + r32) * 32 + hi * 8;
#pragma unroll
    for (int pp = 0; pp < 2; ++pp) {
      const v4u wa = *reinterpret_cast<const v4u*>(Qw + 128 + 16 * pp), wb = *reinterpret_cast<const v4u*>(Qw + 128 + 32 + 16 * pp);
      const unsigned a[4] = {wa.x, wa.y, wa.z, wa.w}, b[4] = {wb.x, wb.y, wb.z, wb.w}; unsigned oa[4], ob[4];
#pragma unroll
      for (int k = 0; k < 4; ++k) { const f32x2 cs0 = rp[16 * pp + 2 * k], cs1 = rp[16 * pp + 2 * k + 1];
        const float x0 = bflo(a[k]), x1 = bfhi(a[k]), y0 = bflo(b[k]), y1 = bfhi(b[k]);
        oa[k] = cvtpk(x0 * cs0.x - y0 * cs0.y, x1 * cs1.x - y1 * cs1.y);
        ob[k] = cvtpk(y0 * cs0.x + x0 * cs0.y, y1 * cs1.x + x1 * cs1.y); }
      qr[8 + pp] = __builtin_bit_cast(bf16x8, (v4u){oa[0], oa[1], oa[2], oa[3]}); qr[10 + pp] = __builtin_bit_cast(bf16x8, (v4u){ob[0], ob[1], ob[2], ob[3]}); }
  }
  const int sr = tid >> 4, sc = (tid & 15) * 8, vst0 = v_st(sr, sc), vst1 = v_st(32 + sr, sc);
  const int pr = tid >> 3, pc = (tid & 7) * 8;
  const int vb0 = (int)(uintptr_t)V_lds + v_rd_base(lane);
  const bf16* gkv = KVh + (size_t)sr * NKV + sc; const bf16* gkp = KPb + (size_t)pr * DROPE + pc;
  const int kst0 = KSWZ(sr, sc * 2), kst1 = KSWZ(32 + sr, sc * 2), kst2 = KSWZ(pr, 256 + pc * 2);
  bf16x8 vs0, vs1, ks0, ks1, ks2;
#define SLOAD(k0) do { const bf16* g_ = gkv + (size_t)(k0) * NKV; ks0 = *reinterpret_cast<const bf16x8*>(g_); vs0 = *reinterpret_cast<const bf16x8*>(g_ + 128); \
    ks1 = *reinterpret_cast<const bf16x8*>(g_ + 32 * NKV); vs1 = *reinterpret_cast<const bf16x8*>(g_ + 32 * NKV + 128); ks2 = *reinterpret_cast<const bf16x8*>(gkp + (size_t)(k0) * DROPE); } while (0)
#define SWRITE(b) do { *(bf16x8*)(V_lds + (b) * SHM_V + vst0) = vs0; *(bf16x8*)(V_lds + (b) * SHM_V + vst1) = vs1; \
    *(bf16x8*)(K_lds + (b) * SHM_K + kst0) = ks0; *(bf16x8*)(K_lds + (b) * SHM_K + kst1) = ks1; *(bf16x8*)(K_lds + (b) * SHM_K + kst2) = ks2; } while (0)
#define SWAIT() asm volatile("s_waitcnt vmcnt(0)" ::: "memory")
#define RESC(a) do { if (__any((a) < 1.f)) { if (hi == 0) al_l[r32] = (a); asm volatile("s_waitcnt lgkmcnt(0)" ::: "memory"); \
    _Pragma("unroll") for (int d = 0; d < 4; ++d) _Pragma("unroll") for (int r = 0; r < 16; ++r) o[d][r] *= al_l[crow(r, hi)]; } } while (0)
  f32x16 p0, p1; float mn, al; bf16x8 pa0, pa1, pa2, pa3; constexpr int NT = SEQ / KVBLK;
  SLOAD(0); SWAIT(); SWRITE(0); __syncthreads();
  for (int j = 0; j < NT; ++j) {
    const int bsel = j & 1;
    SBAR(); qkt(p0, p1, K_lds + bsel * SHM_K, qr, r32, hi); SBAR();
    if (j + 1 < NT) SLOAD((j + 1) * KVBLK);
    SBAR();
    partialSM(p0, p1, m_reg, mn, al); RESC(al);
    finishSM(p0, p1, al, l_reg, pa0, pa1, pa2, pa3); SBAR();
    pv_d0(o, vb0 + bsel * SHM_V, pa0, pa1, pa2, pa3);
    if (j + 1 < NT) { SWAIT(); SWRITE(bsel ^ 1); }
    __syncthreads();
  }
  if (hi == 0) li_l[r32] = l_reg; asm volatile("s_waitcnt lgkmcnt(0)" ::: "memory");
  float rli[16];
#pragma unroll
  for (int r = 0; r < 16; ++r) rli[r] = __builtin_amdgcn_rcpf(li_l[crow(r, hi)]);
  bf16* Ow = Ob + (size_t)(wid * QBLK) * AW;
#pragma unroll
  for (int r = 0; r < 16; ++r) { int orow = crow(r, hi);
#pragma unroll
    for (int d0 = 0; d0 < 4; ++d0) Ow[(size_t)orow * AW + d0 * 32 + r32] = (bf16)f2bf(o[d0][r] * rli[r]); }
  __syncthreads();
#undef SLOAD
#undef SWRITE
#undef SWAIT
#undef RESC
}
}

__device__ __forceinline__ void p5_attention(Frame& F) {
    const bf16* Q = (const bf16*)(F.ws + WS_Q); const bf16* KV = (const bf16*)(F.ws + WS_KV); const bf16* KPE = (const bf16*)(F.ws + WS_KPE); bf16* O = (bf16*)(F.ws + WS_O);
    const f32x2* ROPE = (const f32x2*)(F.ws + WS_ROPE);
    for (int unit = F.vcu; unit < BATCH * NH * 8; unit += F.G) {
        const int qb = unit & 7, bh = unit >> 3, b = bh >> 3, h = bh & 7; const size_t m0 = (size_t)b * SEQ + qb * 256;
        att::attn_unit(Q + m0 * NQ + h * DQK, KV + (size_t)b * SEQ * NKV + h * 256, KPE + (size_t)b * SEQ * DROPE, O + m0 * AW + h * DV, ROPE + qb * 256 * 32, F.ldsg);
    }
}

__device__ __forceinline__ void p6_mixnorm(Frame& F) {
    const bf16* O = (const bf16*)(F.ws + WS_O); const bf16* YT = (const bf16*)(F.ws + WS_YT); bf16* MIXIN = (bf16*)(F.ws + WS_MIXIN);
    const float* gh = F.in[17]; const float* ga = F.in[18];
    const int gw = F.vcu * NWAVES + F.wave, NGW = F.G * NWAVES, lane = F.lane, tid = F.tid;
    for (int m0 = gw; m0 < M; m0 += NGW * 2) {
        v4u w[2][2];
#pragma unroll
        for (int u = 0; u < 2; ++u)
#pragma unroll
            for (int j = 0; j < 2; ++j) w[u][j] = __builtin_nontemporal_load((const v4u*)(O + (size_t)(m0 + u * NGW) * AW + 8 * (lane + 64 * j)));
#pragma unroll
        for (int u = 0; u < 2; ++u) { const int m = m0 + u * NGW; float s = 0.f;
#pragma unroll
            for (int j = 0; j < 2; ++j) { const unsigned a[4] = {w[u][j].x, w[u][j].y, w[u][j].z, w[u][j].w};
#pragma unroll
                for (int k = 0; k < 4; ++k) { const float x0 = bflo(a[k]), x1 = bfhi(a[k]); s += x0 * x0 + x1 * x1; } }
            const float r = 1.f / sqrtf(wave_sum(s) * (1.f / AW) + EPS);
#pragma unroll
            for (int j = 0; j < 2; ++j) { const int c = 8 * (lane + 64 * j); const unsigned a[4] = {w[u][j].x, w[u][j].y, w[u][j].z, w[u][j].w}; unsigned o[4];
                const f32x4 g0 = *(const f32x4*)(ga + c), g1 = *(const f32x4*)(ga + c + 4); const float g[8] = {g0.x, g0.y, g0.z, g0.w, g1.x, g1.y, g1.z, g1.w};
#pragma unroll
                for (int k = 0; k < 4; ++k) o[k] = pk2(bflo(a[k]) * r * g[2 * k], bfhi(a[k]) * r * g[2 * k + 1]);
                *(v4u*)(MIXIN + (size_t)m * DM + HW + c) = (v4u){o[0], o[1], o[2], o[3]}; } }
    }
    LAS bf16* T = (LAS bf16*)F.lds; constexpr int TP = 1026;
    for (int unit = F.vcu; unit < BATCH * 64; unit += F.G) {
        const int b = unit >> 6, s0 = (unit & 63) * 32;
        __syncthreads();
#pragma unroll
        for (int i = 0; i < 8; ++i) { const int ch = tid & 3, c = (tid >> 2) + 128 * i;
            const v4u w = __builtin_nontemporal_load((const v4u*)(YT + ((size_t)c * BATCH + b) * SEQ + s0 + ch * 8)); const unsigned a[4] = {w.x, w.y, w.z, w.w};
#pragma unroll
            for (int k = 0; k < 4; ++k) { T[(ch * 8 + 2 * k) * TP + c] = (bf16)(a[k] & 0xffffu); T[(ch * 8 + 2 * k + 1) * TP + c] = (bf16)(a[k] >> 16); } }
        __syncthreads();
#pragma unroll
        for (int q = 0; q < 4; ++q) { const int sl = F.wave * 4 + q; unsigned v[8]; float s = 0.f;
#pragma unroll
            for (int k = 0; k < 8; ++k) { v[k] = *(const LAS unsigned*)(T + sl * TP + 2 * lane + 128 * k); const float x0 = bflo(v[k]), x1 = bfhi(v[k]); s += x0 * x0 + x1 * x1; }
            const float r = 1.f / sqrtf(wave_sum(s) * (1.f / HW) + EPS);
            bf16* orow = MIXIN + ((size_t)b * SEQ + s0 + sl) * DM;
#pragma unroll
            for (int k = 0; k < 8; ++k) { const int c = 2 * lane + 128 * k; const f32x2 g = *(const f32x2*)(gh + c);
                *(unsigned*)(orow + c) = pk2(bflo(v[k]) * r * g.x, bfhi(v[k]) * r * g.y); } }
    }
    __syncthreads();
}

__device__ __forceinline__ void p8_postmix(Frame& F) {
    const bf16* MIXED = (const bf16*)(F.ws + WS_MIXED); bf16* XN = (bf16*)(F.ws + WS_XN);
    const float* x = F.in[0]; const float* gpost = F.in[20]; const float* gpre = F.in[21]; bf16* H16 = (bf16*)(F.ws + WS_H16);
    const int gw = F.vcu * NWAVES + F.wave, NGW = F.G * NWAVES, lane = F.lane;
    for (int m = gw; m < M; m += NGW) {
        float mx[32]; float s = 0.f;
#pragma unroll
        for (int j = 0; j < 4; ++j) { const v4u w = *(const v4u*)(MIXED + (size_t)m * DM + 8 * (lane + 64 * j)); const unsigned a[4] = {w.x, w.y, w.z, w.w};
#pragma unroll
            for (int k = 0; k < 4; ++k) { mx[8 * j + 2 * k] = bflo(a[k]); mx[8 * j + 2 * k + 1] = bfhi(a[k]); s += mx[8 * j + 2 * k] * mx[8 * j + 2 * k] + mx[8 * j + 2 * k + 1] * mx[8 * j + 2 * k + 1]; } }
        const float r = 1.f / sqrtf(wave_sum(s) * (1.f / DM) + EPS);
        float s2 = 0.f;
#pragma unroll
        for (int j = 0; j < 4; ++j) { const int c = 8 * (lane + 64 * j);
#pragma unroll
            for (int hh = 0; hh < 2; ++hh) { const f32x4 xv = *(const f32x4*)(x + (size_t)m * DM + c + 4 * hh); const f32x4 g = *(const f32x4*)(gpost + c + 4 * hh);
                f32x4 hv; hv.x = xv.x + mx[8 * j + 4 * hh] * r * g.x; hv.y = xv.y + mx[8 * j + 4 * hh + 1] * r * g.y; hv.z = xv.z + mx[8 * j + 4 * hh + 2] * r * g.z; hv.w = xv.w + mx[8 * j + 4 * hh + 3] * r * g.w;
                mx[8 * j + 4 * hh] = hv.x; mx[8 * j + 4 * hh + 1] = hv.y; mx[8 * j + 4 * hh + 2] = hv.z; mx[8 * j + 4 * hh + 3] = hv.w;
                s2 += (hv.x * hv.x + hv.y * hv.y) + (hv.z * hv.z + hv.w * hv.w); } }
        const float s2t = wave_sum(s2); if (lane == 0) ((float*)(F.ws + WS_SS2))[m] = s2t;
        const float r2 = 1.f / sqrtf(s2t * (1.f / DM) + EPS);
#pragma unroll
        for (int j = 0; j < 4; ++j) { const int c = 8 * (lane + 64 * j); const f32x4 g0 = *(const f32x4*)(gpre + c), g1 = *(const f32x4*)(gpre + c + 4);
            { v4u hq; hq.x = pk2(mx[8 * j], mx[8 * j + 1]); hq.y = pk2(mx[8 * j + 2], mx[8 * j + 3]); hq.z = pk2(mx[8 * j + 4], mx[8 * j + 5]); hq.w = pk2(mx[8 * j + 6], mx[8 * j + 7]);
              *(v4u*)(H16 + (size_t)m * DM + c) = hq; }
            v4u o; o.x = pk2(mx[8 * j] * r2 * g0.x, mx[8 * j + 1] * r2 * g0.y); o.y = pk2(mx[8 * j + 2] * r2 * g0.z, mx[8 * j + 3] * r2 * g0.w);
            o.z = pk2(mx[8 * j + 4] * r2 * g1.x, mx[8 * j + 5] * r2 * g1.y); o.w = pk2(mx[8 * j + 6] * r2 * g1.z, mx[8 * j + 7] * r2 * g1.w);
            *(v4u*)(XN + (size_t)m * DM + c) = o; }
    }
}
__device__ __forceinline__ void p10_fixup(Frame& F) {
    const f32x4* BB = (const f32x4*)(F.ws + WS_BB); bf16* ACT = (bf16*)(F.ws + WS_ACT);
    const float* cw = F.in[23];
    constexpr int UB = 8, NE = 512 * DFF;
    const int stride = F.G * NTHR;
    for (int i0 = F.vcu * NTHR + F.tid; i0 < NE; i0 += stride * UB) {
        f32x4 v[UB]; float gn[UB], wn[UB]; int rr[UB], cc[UB]; bool ok[UB];
#pragma unroll
        for (int u = 0; u < UB; ++u) { int i = i0 + u * stride; ok[u] = (i < NE); i = ok[u] ? i : i0;
            const int q = i / DFF, c = i - q * DFF, chunk = q >> 1, last = q & 1; const int r = chunk * 64 + (last ? 63 : 0);
            const bool un = last ? (((r + 1) & (SEQ - 1)) != 0) : ((r & (SEQ - 1)) != 0);
            const int ni = un ? (last ? i + DFF : i - DFF) : i;
            v[u] = BB[i]; gn[u] = un ? BB[ni].y : 0.f; wn[u] = cw[(last ? 2 * DFF : 0) + c]; rr[u] = r; cc[u] = c; }
#pragma unroll
        for (int u = 0; u < UB; ++u) { const float pre = v[u].x + wn[u] * gn[u];
            if (ok[u]) ACT[(size_t)rr[u] * DFF + cc[u]] = (bf16)f2bf(pg8::gelu_tanh(pre) * v[u].z); }
    }
}
__device__ __forceinline__ void p12_final(Frame& F) {
    const bf16* FB = (const bf16*)(F.ws + WS_F); const bf16* H16 = (const bf16*)(F.ws + WS_H16); const float* g = F.in[26]; float* out = F.out;
    const int gw = F.vcu * NWAVES + F.wave, NGW = F.G * NWAVES, lane = F.lane;
    for (int m = gw; m < M; m += NGW) {
        float fx[32]; float s = 0.f; v4u hw[4];
#pragma unroll
        for (int j = 0; j < 4; ++j) { const v4u w = *(const v4u*)(FB + (size_t)m * DM + 8 * (lane + 64 * j)); hw[j] = *(const v4u*)(H16 + (size_t)m * DM + 8 * (lane + 64 * j)); const unsigned a[4] = {w.x, w.y, w.z, w.w};
#pragma unroll
            for (int k = 0; k < 4; ++k) { fx[8 * j + 2 * k] = bflo(a[k]); fx[8 * j + 2 * k + 1] = bfhi(a[k]); s += fx[8 * j + 2 * k] * fx[8 * j + 2 * k] + fx[8 * j + 2 * k + 1] * fx[8 * j + 2 * k + 1]; } }
        const float r = 1.f / sqrtf(wave_sum(s) * (1.f / DM) + EPS);
#pragma unroll
        for (int j = 0; j < 4; ++j) { const int c = 8 * (lane + 64 * j); const unsigned hh4[4] = {hw[j].x, hw[j].y, hw[j].z, hw[j].w};
#pragma unroll
            for (int hh = 0; hh < 2; ++hh) { float* p = out + (size_t)m * DM + c + 4 * hh; const f32x4 gg = *(const f32x4*)(g + c + 4 * hh);
                f32x4 ov; ov.x = bflo(hh4[2 * hh]) + fx[8 * j + 4 * hh] * r * gg.x; ov.y = bfhi(hh4[2 * hh]) + fx[8 * j + 4 * hh + 1] * r * gg.y;
                ov.z = bflo(hh4[2 * hh + 1]) + fx[8 * j + 4 * hh + 2] * r * gg.z; ov.w = bfhi(hh4[2 * hh + 1]) + fx[8 * j + 4 * hh + 3] * r * gg.w;
                *(f32x4*)p = ov; } }
    }
}

struct Args { const float* in[27]; float* out; unsigned char* ws; int ph_lo, ph_hi; };
template <bool COOP>
__global__ void __launch_bounds__(NTHR, 2) mk_fwd(Args args) {
    extern __shared__ __attribute__((aligned(16))) unsigned char lds[];
    Frame F;
    F.lds = (LAS unsigned char*)lds; F.ldsg = (char*)lds;
    F.tid = threadIdx.x; F.lane = F.tid & 63; F.wave = __builtin_amdgcn_readfirstlane(F.tid >> 6);
    F.G = gridDim.x; { const int bx = blockIdx.x; F.vcu = (F.G % 8 == 0) ? (bx % 8) * (F.G / 8) + bx / 8 : bx; }
#pragma unroll
    for (int i = 0; i < 27; ++i) F.in[i] = args.in[i];
    F.out = args.out; F.ws = args.ws;
    unsigned char* ws = args.ws;
    const int lo = args.ph_lo, hi = args.ph_hi;
    volatile LAS unsigned* MISC = (volatile LAS unsigned*)(F.lds + 131072 + 320);
    XcdBarrier bar; bar.bar = (unsigned*)ws; bar.x = 0; bar.st = nullptr;
    if (COOP) { if (F.tid < 32) MISC[F.tid] = 0u; __syncthreads(); bar = xcd_barrier_post((unsigned*)ws, MISC + 8);
        p0_pre(F);
        if (F.G != 256) cg::this_grid().sync(); }
#ifndef PROBE_REP
#define PROBE_REP 0
#endif
#define REP(k) for (int rep_ = 0; rep_ < 1 + ((PROBE_REP >> (k)) & 1); ++rep_)
#define IN(k) (lo <= (k) && (k) < hi)
#define SEAM(k) do { if (COOP && IN((k) + 1)) xcd_barrier(bar); } while (0)
#ifndef SKIP_P0
    if (IN(0)) { REP(0) p0_prologue(F); SEAM(0); }
#endif
    if (IN(1)) { pg8::Gemm g{(const bf16*)(ws + WS_XN), (const bf16*)(ws + WS_WIN), M, INWP, DM}; pg8::StaticOrder S; S.init(M, INWP, F.G, (int)blockIdx.x);
        pg8::EpiStore E{(bf16*)(ws + WS_PROJ), INWP};
        pg8::gemm_phase<pg8::EpiStore, pg8::StaticOrder, true, true>(F.lds, g, S, E); SEAM(1); }
    if (IN(2)) { REP(2) { p2_hyena_prep(F); p2_mla_prep(F); p2_filter_out(F); } SEAM(2); }
    if (IN(3)) {
#ifndef SKIP_LC
        REP(3) p4_longconv(F);
#endif
        { pg8::Gemm g{(const bf16*)(ws + WS_CQN), (const bf16*)(ws + WS_WUQ), M, NQ, QLR}; pg8::StaticOrder S; S.init(M, NQ, F.G, (int)blockIdx.x);
          pg8::EpiStore E{(bf16*)(ws + WS_Q), NQ};
          pg8::gemm_phase<pg8::EpiStore, pg8::StaticOrder, true, true>(F.lds, g, S, E); }
        { pg8::Gemm g{(const bf16*)(ws + WS_CKVN), (const bf16*)(ws + WS_WUKV), M, NKV, KVLR}; pg8::StaticOrder S; S.init(M, NKV, F.G, (int)blockIdx.x);
          pg8::EpiStore E{(bf16*)(ws + WS_KV), NKV};
          pg8::gemm_phase<pg8::EpiStore, pg8::StaticOrder, true, true>(F.lds, g, S, E); }
        SEAM(3); }
    #ifndef SKIP_ATT
    if (IN(4)) { REP(4) p5_attention(F); SEAM(4); }
#endif
    if (IN(5)) { REP(5) p6_mixnorm(F); SEAM(5); }
    const bool fused = (F.G == 256);
    if (IN(6)) { pg8::Gemm g{(const bf16*)(ws + WS_MIXIN), (const bf16*)(ws + WS_WOUT), M, DM, DM}; pg8::StaticOrder S; S.init(M, DM, F.G, (int)blockIdx.x);
        if (fused) { pg8::EpiMixRes E{(bf16*)(ws + WS_MIXED), F.in[0], F.in[20], (bf16*)(ws + WS_H16), (float*)(ws + WS_SS1), (float*)(ws + WS_SS2), (unsigned*)(ws + WS_CNT), DM, EPS};
            pg8::gemm_phase<pg8::EpiMixRes, pg8::StaticOrder, true, true>(F.lds, g, S, E); }
        else { pg8::EpiStore E{(bf16*)(ws + WS_MIXED), DM};
            pg8::gemm_phase<pg8::EpiStore, pg8::StaticOrder, true, true>(F.lds, g, S, E); if (COOP) xcd_barrier(bar); p8_postmix(F); }
        SEAM(7); }
#ifndef SKIP_GEGLU
    if (IN(8)) { pg8::Gemm g{(const bf16*)(ws + WS_H16), (const bf16*)(ws + WS_WUP), M, 2 * DFF, DM}; pg8::StaticOrder S; S.init(M, 2 * DFF, F.G, (int)blockIdx.x);
        pg8::EpiGeglu E{(bf16*)(ws + WS_ACT), F.in[23], F.in[24], (pg8::f32x4*)(ws + WS_BB), DFF, (const float*)(ws + WS_SS2), EPS};
        pg8::gemm_phase<pg8::EpiGeglu, pg8::StaticOrder, true, true>(F.lds, g, S, E); SEAM(8); }
#endif
    if (IN(9)) { REP(9) p10_fixup(F); SEAM(9); }
    if (IN(10)) { pg8::Gemm g{(const bf16*)(ws + WS_ACT), (const bf16*)(ws + WS_WDOWN), M, DM, DFF}; pg8::StaticOrder S; S.init(M, DM, F.G, (int)blockIdx.x);
        if (fused) { pg8::EpiFinal E{(bf16*)(ws + WS_F), (const bf16*)(ws + WS_H16), F.in[26], F.out, (float*)(ws + WS_SS3), (unsigned*)(ws + WS_CNT2), DM, EPS};
            pg8::gemm_phase<pg8::EpiFinal, pg8::StaticOrder, true, true>(F.lds, g, S, E); }
        else { pg8::EpiStore E{(bf16*)(ws + WS_F), DM};
            pg8::gemm_phase<pg8::EpiStore, pg8::StaticOrder, true, true>(F.lds, g, S, E); if (COOP) xcd_barrier(bar); p12_final(F); } }
#undef IN
#undef SEAM
}

extern "C" void kernel_launch(void* const* d_in, const int* in_sizes, int n_in, void* d_out, int out_size, void* d_ws, size_t ws_size, hipStream_t stream) {
    static int grid = 0;
    if (grid == 0) {
        if (n_in != 27 || in_sizes[0] != M * DM || out_size != M * DM || ws_size < WS_END) { fprintf(stderr, "kernel_launch: unexpected shapes: n_in %d in0 %d out %d ws %zu (need %zu)\n", n_in, n_in > 0 ? in_sizes[0] : -1, out_size, ws_size, (size_t)WS_END); grid = -1; return; }
        int dev = 0, cus = 0;
        if (hipGetDevice(&dev) != hipSuccess || hipDeviceGetAttribute(&cus, hipDeviceAttributeMultiprocessorCount, dev) != hipSuccess) { grid = -1; return; }
        if (hipFuncSetAttribute((const void*)mk_fwd<true>, hipFuncAttributeMaxDynamicSharedMemorySize, LDS_BYTES) != hipSuccess ||
            hipFuncSetAttribute((const void*)mk_fwd<false>, hipFuncAttributeMaxDynamicSharedMemorySize, LDS_BYTES) != hipSuccess) { fprintf(stderr, "kernel_launch: hipFuncSetAttribute failed\n"); grid = -1; return; }
        int per_cu = 0;
        if (hipOccupancyMaxActiveBlocksPerMultiprocessor(&per_cu, (const void*)mk_fwd<true>, NTHR, LDS_BYTES) != hipSuccess || per_cu < 1) { fprintf(stderr, "kernel_launch: occupancy query says %d\n", per_cu); }
        (void)hipGetLastError();
        grid = cus;
    }
    if (grid < 0) return;
    Args a{};
    for (int i = 0; i < 27; ++i) a.in[i] = (const float*)d_in[i];
    a.out = (float*)d_out; a.ws = (unsigned char*)d_ws;
    if (MK_N_LAUNCHES == 1) {
        a.ph_lo = 0; a.ph_hi = 12;
        if (hipMemsetAsync(d_ws, 0, CTL_BYTES, stream) != hipSuccess) { fprintf(stderr, "kernel_launch: memset failed\n"); return; }
        void* kargs[] = {&a};
        hipError_t e = hipLaunchCooperativeKernel((const void*)mk_fwd<true>, dim3(grid), dim3(NTHR), kargs, LDS_BYTES, stream);
        if (e != hipSuccess) fprintf(stderr, "kernel_launch: cooperative launch failed: %s (grid %d)\n", hipGetErrorString(e), grid);
    } else {
        for (int p = 0; p < 12; ++p) { a.ph_lo = p; a.ph_hi = p + 1;
            hipLaunchKernelGGL(mk_fwd<false>, dim3(grid), dim3(NTHR), LDS_BYTES, stream, a);
            const hipError_t le = hipPeekAtLastError();
            if (le != hipSuccess) { fprintf(stderr, "kernel_launch: launch %d failed: %s\n", p, hipGetErrorName(le)); break; } }
    }
}
```

```cpp
#include <hip/hip_runtime.h>
#include <hip/hip_cooperative_groups.h>
#include <cstdio>
#include <cstdint>
namespace cg = cooperative_groups;
#ifndef MK_N_LAUNCHES
#define MK_N_LAUNCHES 1
#endif
namespace pg8 {
#define PG8_LAS __attribute__((address_space(3)))
typedef unsigned short bf16_t;
typedef short bf16x8 __attribute__((ext_vector_type(8)));
typedef float f32x4 __attribute__((ext_vector_type(4)));
typedef unsigned u32x4 __attribute__((ext_vector_type(4)));
constexpr int BM = 256, BK = 64, HALF = 128, HTB = HALF * BK * 2  , STAGE_BYTES = 8 * HTB, NXCD = 8, WGM = 8;

__host__ __device__ __forceinline__ int lds_byte(int r, int c) { const int st = (r >> 4) * 2 + (c >> 5), rr = r & 15, cc = c & 31, ob = rr * 64 + cc * 2; return st * 1024 + (ob ^ (((ob >> 9) & 1) << 5)); }
__host__ __device__ __forceinline__ void stage_rc(int b, int& R, int& C) { const int st = b / 1024, sb = b % 1024, swz = sb ^ (((sb >> 9) & 1) << 5); R = (st >> 1) * 16 + swz / 64; C = (st & 1) * 32 + (swz % 64) / 2; }
__host__ __device__ __forceinline__ int perm32(int rho) { const int n = rho >> 4, i = rho & 15; return 8 * (i >> 2) + 4 * n + (i & 3); }

struct Unit { int pm, pn; };
struct Gemm { const bf16_t* A; const bf16_t* Bt; int M, N, K; };

struct StaticOrder {
    int nM, nN, nwg, G, c;
    __host__ __device__ void init(int M, int N, int G_, int c_) { nM = M / BM; nN = N / BM; nwg = nM * nN; G = G_; c = c_; }
    __host__ __device__ bool next(int i, Unit& u) const {
        const long L = (long)i * G + c; if (L >= nwg) return false;
        int wgid = (int)L; { const int q = nwg / NXCD, r = nwg % NXCD, xcd = wgid % NXCD, off = wgid / NXCD; wgid = (xcd < r ? xcd * (q + 1) : r * (q + 1) + (xcd - r) * q) + off; }
        const int nig = WGM * nN, gid = wgid / nig, fm = gid * WGM, gsz = (nM - fm) < WGM ? (nM - fm) : WGM;
        u.pm = fm + ((wgid % nig) % gsz); u.pn = (wgid % nig) / gsz; return true;
    }
    __device__ __forceinline__ void a_ready(const Unit&) const {}
    __device__ __forceinline__ void done(const Unit&) const {}
};

__device__ __forceinline__ unsigned cvt_pk_bf16(float lo, float hi) { unsigned r; asm volatile("v_cvt_pk_bf16_f32 %0, %1, %2" : "=v"(r) : "v"(lo), "v"(hi)); return r; }
typedef float f32x2 __attribute__((ext_vector_type(2)));

struct EpiStore {
    static constexpr bool PERM = true, AFTER_DRAIN = false;
    bf16_t* O; int ldc;
    __device__ __forceinline__ void operator()(const f32x4 (&acc)[2][2][4][2], const Unit& u, int wr, int wc, int fr, int fq) const {
        const int row0 = u.pm * BM + wr * 64 + fr; const int col0 = u.pn * BM + wc * 32 + 8 * fq;
#pragma unroll
        for (int ai = 0; ai < 2; ++ai)
#pragma unroll
            for (int m = 0; m < 4; ++m) { bf16_t* rowp = O + (size_t)(row0 + ai * HALF + m * 16) * ldc + col0;
#pragma unroll
                for (int bj = 0; bj < 2; ++bj) { const f32x4 v0 = acc[ai][bj][m][0], v1 = acc[ai][bj][m][1];
                    u32x4 w; w.x = cvt_pk_bf16(v0[0], v0[1]); w.y = cvt_pk_bf16(v0[2], v0[3]); w.z = cvt_pk_bf16(v1[0], v1[1]); w.w = cvt_pk_bf16(v1[2], v1[3]);
                    *(u32x4*)(rowp + bj * HALF) = w; } }
    }
};

struct EpiMixRes {
    static constexpr bool PERM = true, AFTER_DRAIN = false;
    bf16_t* MIXED; const float* x; const float* gpost; bf16_t* H16; float* SS1; float* SS2; unsigned* CNT; int ldc; float eps;
    __device__ __forceinline__ void fin8(const f32x4& v0, const f32x4& v1, float r1, size_t o, int col, float& s2) const {
        const f32x4 x0 = __builtin_nontemporal_load((const f32x4*)(x + o)), x1 = __builtin_nontemporal_load((const f32x4*)(x + o + 4)), g0 = *(const f32x4*)(gpost + col), g1 = *(const f32x4*)(gpost + col + 4);
        const f32x4 h0 = x0 + (v0 * r1) * g0, h1 = x1 + (v1 * r1) * g1;
        s2 += (h0[0] * h0[0] + h0[1] * h0[1]) + (h0[2] * h0[2] + h0[3] * h0[3]) + (h1[0] * h1[0] + h1[1] * h1[1]) + (h1[2] * h1[2] + h1[3] * h1[3]);
        u32x4 w; w.x = cvt_pk_bf16(h0[0], h0[1]); w.y = cvt_pk_bf16(h0[2], h0[3]); w.z = cvt_pk_bf16(h1[0], h1[1]); w.w = cvt_pk_bf16(h1[2], h1[3]);
        *(u32x4*)(H16 + o) = w;
    }
    __device__ __forceinline__ void operator()(const f32x4 (&acc)[2][2][4][2], const Unit& u, int wr, int wc, int fr, int fq) const {
        const bool second = (u.pn >= 4);
        const int row0 = u.pm * BM + wr * 64 + fr; const int col0 = u.pn * BM + wc * 32 + 8 * fq;
#pragma unroll
        for (int ai = 0; ai < 2; ++ai)
#pragma unroll
            for (int m = 0; m < 4; ++m) { float s = 0.f;
#pragma unroll
                for (int bj = 0; bj < 2; ++bj)
#pragma unroll
                    for (int n = 0; n < 2; ++n) { const f32x4 v = acc[ai][bj][m][n]; s += (v[0] * v[0] + v[1] * v[1]) + (v[2] * v[2] + v[3] * v[3]); }
                s += __shfl_xor(s, 16); s += __shfl_xor(s, 32);
                if (fq == 0) (void)__hip_atomic_fetch_add(SS1 + row0 + ai * HALF + m * 16, s, __ATOMIC_RELAXED, __HIP_MEMORY_SCOPE_AGENT); }
        if (!second) {
#pragma unroll
            for (int ai = 0; ai < 2; ++ai)
#pragma unroll
                for (int m = 0; m < 4; ++m) { bf16_t* rowp = MIXED + (size_t)(row0 + ai * HALF + m * 16) * ldc + col0;
#pragma unroll
                    for (int bj = 0; bj < 2; ++bj) { const f32x4 v0 = acc[ai][bj][m][0], v1 = acc[ai][bj][m][1];
                        u32x4 w; w.x = cvt_pk_bf16(v0[0], v0[1]); w.y = cvt_pk_bf16(v0[2], v0[3]); w.z = cvt_pk_bf16(v1[0], v1[1]); w.w = cvt_pk_bf16(v1[2], v1[3]);
                        *(u32x4*)(rowp + bj * HALF) = w; } }
            return;
        }
        asm volatile("s_waitcnt vmcnt(0)" ::: "memory");
        __builtin_amdgcn_s_barrier();
        if (threadIdx.x == 0) {
            __builtin_amdgcn_fence(__ATOMIC_RELEASE, "agent");
            (void)__hip_atomic_fetch_add(CNT + 64 * u.pm, 1u, __ATOMIC_RELAXED, __HIP_MEMORY_SCOPE_AGENT);
            unsigned sp = 0;
            while (__hip_atomic_load(CNT + 64 * u.pm, __ATOMIC_RELAXED, __HIP_MEMORY_SCOPE_AGENT) < 4u) { __builtin_amdgcn_s_sleep(2); if (++sp > (1u << 22)) break; }
            __builtin_amdgcn_fence(__ATOMIC_ACQUIRE, "agent");
        }
        __builtin_amdgcn_s_barrier();
        asm volatile("" ::: "memory");
#pragma unroll
        for (int ai = 0; ai < 2; ++ai)
#pragma unroll
            for (int m = 0; m < 4; ++m) { const int row = row0 + ai * HALF + m * 16;
                const float r1 = 1.f / sqrtf(__hip_atomic_load(SS1 + row, __ATOMIC_RELAXED, __HIP_MEMORY_SCOPE_AGENT) * (1.f / 2048.f) + eps);
                float s2 = 0.f;
#pragma unroll
                for (int bj = 0; bj < 2; ++bj) {
                    const int col = col0 + bj * HALF; const size_t o = (size_t)row * ldc + col;
                    fin8(acc[ai][bj][m][0], acc[ai][bj][m][1], r1, o, col, s2);
                    const int colp = col - 4 * BM; const size_t op = (size_t)row * ldc + colp;
                    const u32x4 w = *(const u32x4*)(MIXED + op);
                    const f32x4 p0 = {__builtin_bit_cast(float, w.x << 16), __builtin_bit_cast(float, w.x & 0xffff0000u), __builtin_bit_cast(float, w.y << 16), __builtin_bit_cast(float, w.y & 0xffff0000u)};
                    const f32x4 p1 = {__builtin_bit_cast(float, w.z << 16), __builtin_bit_cast(float, w.z & 0xffff0000u), __builtin_bit_cast(float, w.w << 16), __builtin_bit_cast(float, w.w & 0xffff0000u)};
                    fin8(p0, p1, r1, op, colp, s2); }
                s2 += __shfl_xor(s2, 16); s2 += __shfl_xor(s2, 32);
                if (fq == 0) (void)__hip_atomic_fetch_add(SS2 + row, s2, __ATOMIC_RELAXED, __HIP_MEMORY_SCOPE_AGENT); }
    }
};

struct EpiFinal {
    static constexpr bool PERM = true, AFTER_DRAIN = false;
    bf16_t* FB; const bf16_t* H16; const float* gain; float* out; float* SS; unsigned* CNT; int ldc; float eps;
    __device__ __forceinline__ void fin8(const f32x4& v0, const f32x4& v1, float r, size_t o, int col) const {
        const u32x4 hw = __builtin_nontemporal_load((const u32x4*)(H16 + o)); const f32x4 g0 = *(const f32x4*)(gain + col), g1 = *(const f32x4*)(gain + col + 4);
        const f32x4 h0 = {__builtin_bit_cast(float, hw.x << 16), __builtin_bit_cast(float, hw.x & 0xffff0000u), __builtin_bit_cast(float, hw.y << 16), __builtin_bit_cast(float, hw.y & 0xffff0000u)};
        const f32x4 h1 = {__builtin_bit_cast(float, hw.z << 16), __builtin_bit_cast(float, hw.z & 0xffff0000u), __builtin_bit_cast(float, hw.w << 16), __builtin_bit_cast(float, hw.w & 0xffff0000u)};
        __builtin_nontemporal_store(h0 + (v0 * r) * g0, (f32x4*)(out + o)); __builtin_nontemporal_store(h1 + (v1 * r) * g1, (f32x4*)(out + o + 4));
    }
    __device__ __forceinline__ void operator()(const f32x4 (&acc)[2][2][4][2], const Unit& u, int wr, int wc, int fr, int fq) const {
        const bool second = (u.pn >= 4);
        const int row0 = u.pm * BM + wr * 64 + fr; const int col0 = u.pn * BM + wc * 32 + 8 * fq;
#pragma unroll
        for (int ai = 0; ai < 2; ++ai)
#pragma unroll
            for (int m = 0; m < 4; ++m) { float s = 0.f;
#pragma unroll
                for (int bj = 0; bj < 2; ++bj)
#pragma unroll
                    for (int n = 0; n < 2; ++n) { const f32x4 v = acc[ai][bj][m][n]; s += (v[0] * v[0] + v[1] * v[1]) + (v[2] * v[2] + v[3] * v[3]); }
                s += __shfl_xor(s, 16); s += __shfl_xor(s, 32);
                if (fq == 0) (void)__hip_atomic_fetch_add(SS + row0 + ai * HALF + m * 16, s, __ATOMIC_RELAXED, __HIP_MEMORY_SCOPE_AGENT); }
        if (!second) {
#pragma unroll
            for (int ai = 0; ai < 2; ++ai)
#pragma unroll
                for (int m = 0; m < 4; ++m) { bf16_t* rowp = FB + (size_t)(row0 + ai * HALF + m * 16) * ldc + col0;
#pragma unroll
                    for (int bj = 0; bj < 2; ++bj) { const f32x4 v0 = acc[ai][bj][m][0], v1 = acc[ai][bj][m][1];
                        u32x4 w; w.x = cvt_pk_bf16(v0[0], v0[1]); w.y = cvt_pk_bf16(v0[2], v0[3]); w.z = cvt_pk_bf16(v1[0], v1[1]); w.w = cvt_pk_bf16(v1[2], v1[3]);
                        *(u32x4*)(rowp + bj * HALF) = w; } }
            return;
        }
        asm volatile("s_waitcnt vmcnt(0)" ::: "memory");
        __builtin_amdgcn_s_barrier();
        if (threadIdx.x == 0) {
            __builtin_amdgcn_fence(__ATOMIC_RELEASE, "agent");
            (void)__hip_atomic_fetch_add(CNT + 64 * u.pm, 1u, __ATOMIC_RELAXED, __HIP_MEMORY_SCOPE_AGENT);
            unsigned sp = 0;
            while (__hip_atomic_load(CNT + 64 * u.pm, __ATOMIC_RELAXED, __HIP_MEMORY_SCOPE_AGENT) < 4u) { __builtin_amdgcn_s_sleep(2); if (++sp > (1u << 22)) break; }
            __builtin_amdgcn_fence(__ATOMIC_ACQUIRE, "agent");
        }
        __builtin_amdgcn_s_barrier();
        asm volatile("" ::: "memory");
#pragma unroll
        for (int ai = 0; ai < 2; ++ai)
#pragma unroll
            for (int m = 0; m < 4; ++m) { const int row = row0 + ai * HALF + m * 16;
                const float r = 1.f / sqrtf(__hip_atomic_load(SS + row, __ATOMIC_RELAXED, __HIP_MEMORY_SCOPE_AGENT) * (1.f / 2048.f) + eps);
#pragma unroll
                for (int bj = 0; bj < 2; ++bj) {
                    const int col = col0 + bj * HALF; const size_t o = (size_t)row * ldc + col;
                    fin8(acc[ai][bj][m][0], acc[ai][bj][m][1], r, o, col);
                    const int colp = col - 4 * BM; const size_t op = (size_t)row * ldc + colp;
                    const u32x4 w = __builtin_nontemporal_load((const u32x4*)(FB + op));
                    const f32x4 p0 = {__builtin_bit_cast(float, w.x << 16), __builtin_bit_cast(float, w.x & 0xffff0000u), __builtin_bit_cast(float, w.y << 16), __builtin_bit_cast(float, w.y & 0xffff0000u)};
                    const f32x4 p1 = {__builtin_bit_cast(float, w.z << 16), __builtin_bit_cast(float, w.z & 0xffff0000u), __builtin_bit_cast(float, w.w << 16), __builtin_bit_cast(float, w.w & 0xffff0000u)};
                    fin8(p0, p1, r, op, colp); } }
    }
};

__device__ __forceinline__ float gelu_tanh(float x) {
    const float z = 0.7978845608028654f * (x + 0.044715f * x * x * x);
    const float e = __builtin_amdgcn_exp2f(-2.885390081777927f * z);
    return x * __builtin_amdgcn_rcpf(1.f + e);
}
#ifndef MK_DPP
#define MK_DPP 1
#endif
#if MK_DPP
__device__ __forceinline__ float ror1(float v) { return __builtin_bit_cast(float, __builtin_amdgcn_update_dpp(0, __builtin_bit_cast(int, v), 0x121, 0xf, 0xf, true)); }
__device__ __forceinline__ float rol1(float v) { return __builtin_bit_cast(float, __builtin_amdgcn_update_dpp(0, __builtin_bit_cast(int, v), 0x12f, 0xf, 0xf, true)); }
#else
__device__ __forceinline__ float ror1(float v) { const int l = threadIdx.x & 63; return __shfl(v, (l & 48) | ((l - 1) & 15)); }
__device__ __forceinline__ float rol1(float v) { const int l = threadIdx.x & 63; return __shfl(v, (l & 48) | ((l + 1) & 15)); }
#endif

struct EpiGeglu {
    static constexpr bool PERM = true, AFTER_DRAIN = false;
    bf16_t* ACT; const float* cw; const float* cb; f32x4* BB; int dff; const float* SS2; float eps;
    __device__ __forceinline__ void operator()(const f32x4 (&acc)[2][2][4][2], const Unit& u, int wr, int wc, int fr, int fq) const {
        const int gc0 = u.pn * 128 + wc * 32 + 8 * fq;
        f32x2 w0[4], w1[4], w2[4], bb[4];
        { const f32x4 a0 = *(const f32x4*)(cw + gc0), a1 = *(const f32x4*)(cw + gc0 + 4), b0 = *(const f32x4*)(cw + dff + gc0), b1 = *(const f32x4*)(cw + dff + gc0 + 4);
          const f32x4 c0 = *(const f32x4*)(cw + 2 * dff + gc0), c1 = *(const f32x4*)(cw + 2 * dff + gc0 + 4), d0 = *(const f32x4*)(cb + gc0), d1 = *(const f32x4*)(cb + gc0 + 4);
          w0[0] = (f32x2){a0.x, a0.y}; w0[1] = (f32x2){a0.z, a0.w}; w0[2] = (f32x2){a1.x, a1.y}; w0[3] = (f32x2){a1.z, a1.w};
          w1[0] = (f32x2){b0.x, b0.y}; w1[1] = (f32x2){b0.z, b0.w}; w1[2] = (f32x2){b1.x, b1.y}; w1[3] = (f32x2){b1.z, b1.w};
          w2[0] = (f32x2){c0.x, c0.y}; w2[1] = (f32x2){c0.z, c0.w}; w2[2] = (f32x2){c1.x, c1.y}; w2[3] = (f32x2){c1.z, c1.w};
          bb[0] = (f32x2){d0.x, d0.y}; bb[1] = (f32x2){d0.z, d0.w}; bb[2] = (f32x2){d1.x, d1.y}; bb[3] = (f32x2){d1.z, d1.w}; }
        const f32x2 K1 = (f32x2){-2.302208198f, -2.302208198f}, K2 = (f32x2){-0.102943239f, -0.102943239f}, ONE = (f32x2){1.f, 1.f}, ZERO = (f32x2){0.f, 0.f};
        const bool f0 = (fr == 0), f15 = (fr == 15);
#pragma unroll
        for (int ai = 0; ai < 2; ++ai) {
            const int chunk = u.pm * 4 + ai * 2 + wr; const int rbase = chunk * 64;
            f32x4* pF = BB + (size_t)(chunk * 2) * dff + gc0; f32x4* pL = pF + dff;
            unsigned pk[4][4];
            f32x2 rs[4];
#pragma unroll
            for (int m = 0; m < 4; ++m) { const float t = 1.f / sqrtf(SS2[rbase + m * 16 + fr] * (1.f / 2048.f) + eps); rs[m] = (f32x2){t, t}; }
#pragma unroll
            for (int jp = 0; jp < 4; ++jp) { const int n = jp >> 1, e0 = (jp & 1) * 2;
                f32x2 G[4], R[4], L[4];
#pragma unroll
                for (int m = 0; m < 4; ++m) { G[m] = (f32x2){acc[ai][0][m][n][e0], acc[ai][0][m][n][e0 + 1]} * rs[m];
                    R[m] = (f32x2){ror1(G[m].x), ror1(G[m].y)}; L[m] = (f32x2){rol1(G[m].x), rol1(G[m].y)}; }
#pragma unroll
                for (int m = 0; m < 4; ++m) {
                    const f32x2 uu = (f32x2){acc[ai][1][m][n][e0], acc[ai][1][m][n][e0 + 1]} * rs[m];
                    const f32x2 gup = f0 ? (m > 0 ? R[m > 0 ? m - 1 : 0] : ZERO) : R[m];
                    const f32x2 gdn = f15 ? (m < 3 ? L[m < 3 ? m + 1 : 3] : ZERO) : L[m];
                    const f32x2 pre = w0[jp] * gup + (w1[jp] * G[m] + (w2[jp] * gdn + bb[jp]));
                    const f32x2 a = pre * ((pre * pre) * K2 + K1);
                    f32x2 e; e.x = __builtin_amdgcn_exp2f(a.x); e.y = __builtin_amdgcn_exp2f(a.y);
                    const f32x2 d = e + ONE;
                    f32x2 r; r.x = __builtin_amdgcn_rcpf(d.x); r.y = __builtin_amdgcn_rcpf(d.y);
                    const f32x2 o = (pre * uu) * r;
                    pk[m][jp] = cvt_pk_bf16(o.x, o.y);
                    if (m == 0) { if (f0) { pF[2 * jp] = (f32x4){pre.x, G[m].x, uu.x, 0.f}; pF[2 * jp + 1] = (f32x4){pre.y, G[m].y, uu.y, 0.f}; } }
                    if (m == 3) { if (f15) { pL[2 * jp] = (f32x4){pre.x, G[m].x, uu.x, 0.f}; pL[2 * jp + 1] = (f32x4){pre.y, G[m].y, uu.y, 0.f}; } }
                }
            }
#pragma unroll
            for (int m = 0; m < 4; ++m) { u32x4 w; w.x = pk[m][0]; w.y = pk[m][1]; w.z = pk[m][2]; w.w = pk[m][3];
                __builtin_nontemporal_store(w, (u32x4*)(ACT + (size_t)(rbase + m * 16 + fr) * dff + gc0)); }
        }
    }
};

template <class Epi, class Sched, bool ALIGN_EPI = false, bool SP2 = false>
__device__ __forceinline__ void gemm_phase(PG8_LAS unsigned char* lds, const Gemm g, const Sched& S, const Epi& E) {
    const int tid = threadIdx.x, wid = __builtin_amdgcn_readfirstlane(tid >> 6), lane = tid & 63, wr = wid >> 2, wc = wid & 3, fr = lane & 15, fq = lane >> 4;
    const int K = g.K, nt = K / BK;
    unsigned voffA[2], voffB[2];
#pragma unroll
    for (int i = 0; i < 2; ++i) { int R, C; stage_rc(tid * 16 + i * 8192, R, C); const int Rb = Epi::PERM ? ((R & ~31) + perm32(R & 31)) : R;
        voffA[i] = (unsigned)(R * K + C) * 2u; voffB[i] = (unsigned)(Rb * K + C) * 2u; }
    const size_t kstep = (size_t)(BK * 2);
    const size_t hstep = (size_t)HALF * K * 2;
    const size_t tstep = 2 * hstep;
    const unsigned ldsw = (unsigned)wid * 1024u;
    const int aoff = lds_byte(wr * 64 + fr, fq * 8), boff = lds_byte(wc * 32 + fr, fq * 8);
#define PG8_SA(b, h) (((b) * 2 + (h)) * HTB)
#define PG8_SB(b, h) ((4 + (b) * 2 + (h)) * HTB)
#define PG8_STAGE(bufoff, gbase, voff) do { _Pragma("unroll") for (int _i = 0; _i < 2; ++_i) \
        __builtin_amdgcn_global_load_lds((const unsigned*)((const char*)(gbase) + (voff)[_i]), (PG8_LAS unsigned*)(lds + (bufoff) + ldsw + _i * 8192), 16, 0, 0); } while (0)
#define PG8_LDA(dst, b, h) do { _Pragma("unroll") for (int m = 0; m < 4; ++m) _Pragma("unroll") for (int k = 0; k < 2; ++k) dst[m][k] = *(const PG8_LAS bf16x8*)(lds + PG8_SA(b, h) + aoff + m * 2048 + k * 1024); } while (0)
#define PG8_LDB(dst, b, h) do { _Pragma("unroll") for (int n = 0; n < 2; ++n) _Pragma("unroll") for (int k = 0; k < 2; ++k) dst[n][k] = *(const PG8_LAS bf16x8*)(lds + PG8_SB(b, h) + boff + n * 2048 + k * 1024); } while (0)
#define PG8_MMA(ai, bj, At, Bt) do { __builtin_amdgcn_s_setprio(1); _Pragma("unroll") for (int m = 0; m < 4; ++m) _Pragma("unroll") for (int n = 0; n < 2; ++n) _Pragma("unroll") for (int k = 0; k < 2; ++k) \
        acc[ai][bj][m][n] = __builtin_amdgcn_mfma_f32_16x16x32_bf16(Bt[n][k], At[m][k], acc[ai][bj][m][n], 0, 0, 0); __builtin_amdgcn_s_setprio(0); } while (0)
#define PG8_WAIT_V(n) asm volatile("s_waitcnt vmcnt(" #n ")" ::: "memory")
#define PG8_WAIT_L(n) asm volatile("s_waitcnt lgkmcnt(" #n ")" ::: "memory")
#define PG8_BAR __builtin_amdgcn_s_barrier()
#define PG8_SCHED __builtin_amdgcn_sched_barrier(0)
    Unit cur, nxt; int ui = 0;
    if (!S.next(0, cur)) return;
    f32x4 acc[2][2][4][2];
#pragma unroll
    for (int a = 0; a < 2; ++a)
#pragma unroll
        for (int b = 0; b < 2; ++b)
#pragma unroll
            for (int m = 0; m < 4; ++m)
#pragma unroll
                for (int n = 0; n < 2; ++n) acc[a][b][m][n] = (f32x4){0.f, 0.f, 0.f, 0.f};
    bf16x8 At[4][2], B0[2][2], B1[2][2];
    const char* cA = (const char*)g.A + (size_t)cur.pm * tstep; const char* cB = (const char*)g.Bt + (size_t)cur.pn * tstep;
    S.a_ready(cur);
    if constexpr (SP2) {
        PG8_STAGE(PG8_SB(0, 0), cB, voffB); PG8_STAGE(PG8_SB(0, 1), cB + hstep, voffB); PG8_STAGE(PG8_SA(0, 0), cA, voffA); PG8_STAGE(PG8_SA(0, 1), cA + hstep, voffA);
        if (wr == 1) PG8_BAR;
        PG8_WAIT_V(2); PG8_BAR;
        PG8_STAGE(PG8_SB(1, 0), cB + kstep, voffB); PG8_STAGE(PG8_SA(1, 0), cA + kstep, voffA); PG8_STAGE(PG8_SB(1, 1), cB + hstep + kstep, voffB);
        PG8_WAIT_V(6); PG8_BAR;
    } else {
        PG8_STAGE(PG8_SB(0, 0), cB, voffB); PG8_STAGE(PG8_SA(0, 0), cA, voffA); PG8_STAGE(PG8_SB(0, 1), cB + hstep, voffB); PG8_STAGE(PG8_SA(0, 1), cA + hstep, voffA);
        if (wr == 1) PG8_BAR;
        PG8_WAIT_V(4); PG8_BAR;
        PG8_STAGE(PG8_SB(1, 0), cB + kstep, voffB); PG8_STAGE(PG8_SA(1, 0), cA + kstep, voffA); PG8_STAGE(PG8_SB(1, 1), cB + hstep + kstep, voffB);
        PG8_WAIT_V(6); PG8_BAR;
    }
    for (;;) {
        const bool has_next = S.next(ui + 1, nxt);
        const char* nA = has_next ? (const char*)g.A + (size_t)nxt.pm * tstep : cA; const char* nB = has_next ? (const char*)g.Bt + (size_t)nxt.pn * tstep : cB;
        for (int t = 0; t < nt; t += 2) {
            const bool last = (t == nt - 2);
            const char* a1 = cA + (size_t)(t + 1) * kstep;
            const char* a2 = last ? nA : cA + (size_t)(t + 2) * kstep; const char* b2 = last ? nB : cB + (size_t)(t + 2) * kstep;
            const char* a3 = a2 + kstep; const char* b3 = b2 + kstep;
            if (last && has_next) S.a_ready(nxt);
            if constexpr (SP2) {
            PG8_LDB(B0, 0, 0); PG8_LDB(B1, 0, 1); PG8_SCHED; PG8_LDA(At, 0, 0); PG8_STAGE(PG8_SA(1, 1), a1 + hstep, voffA);
            PG8_WAIT_V(8); PG8_WAIT_L(0); PG8_BAR; PG8_MMA(0, 0, At, B0); PG8_MMA(0, 1, At, B1); PG8_BAR; PG8_SCHED;
            PG8_LDA(At, 0, 1); PG8_STAGE(PG8_SB(0, 0), b2, voffB); PG8_STAGE(PG8_SB(0, 1), b2 + hstep, voffB); PG8_STAGE(PG8_SA(0, 0), a2, voffA);
            PG8_WAIT_V(8); PG8_WAIT_L(0); PG8_BAR; PG8_MMA(1, 0, At, B0); PG8_MMA(1, 1, At, B1); PG8_BAR; PG8_SCHED;
            PG8_LDB(B0, 1, 0); PG8_LDB(B1, 1, 1); PG8_SCHED; PG8_LDA(At, 1, 0); PG8_STAGE(PG8_SA(0, 1), a2 + hstep, voffA);
            PG8_WAIT_V(8); PG8_WAIT_L(0); PG8_BAR; PG8_MMA(0, 0, At, B0); PG8_MMA(0, 1, At, B1); PG8_BAR; PG8_SCHED;
            PG8_LDA(At, 1, 1); PG8_STAGE(PG8_SB(1, 0), b3, voffB); PG8_STAGE(PG8_SB(1, 1), b3 + hstep, voffB); PG8_STAGE(PG8_SA(1, 0), a3, voffA);
            PG8_WAIT_V(8); PG8_WAIT_L(0); PG8_BAR; PG8_MMA(1, 0, At, B0); PG8_MMA(1, 1, At, B1); PG8_BAR; PG8_SCHED;
            } else {
            PG8_LDB(B0, 0, 0); PG8_SCHED; PG8_LDA(At, 0, 0); PG8_STAGE(PG8_SA(1, 1), a1 + hstep, voffA);
            PG8_WAIT_L(8); PG8_BAR; PG8_WAIT_L(0); PG8_MMA(0, 0, At, B0); PG8_BAR; PG8_SCHED;
            PG8_LDB(B1, 0, 1); PG8_STAGE(PG8_SB(0, 0), b2, voffB);
            PG8_BAR; PG8_WAIT_L(0); PG8_MMA(0, 1, At, B1); PG8_BAR;
            PG8_LDA(At, 0, 1); PG8_STAGE(PG8_SA(0, 0), a2, voffA);
            PG8_BAR; PG8_WAIT_L(0); PG8_MMA(1, 0, At, B0); PG8_BAR; PG8_SCHED;
            PG8_STAGE(PG8_SB(0, 1), b2 + hstep, voffB);
            PG8_WAIT_V(6); PG8_BAR; PG8_MMA(1, 1, At, B1); PG8_BAR;
            PG8_LDB(B0, 1, 0); PG8_SCHED; PG8_LDA(At, 1, 0); PG8_STAGE(PG8_SA(0, 1), a2 + hstep, voffA);
            PG8_WAIT_L(8); PG8_BAR; PG8_WAIT_L(0); PG8_MMA(0, 0, At, B0); PG8_BAR; PG8_SCHED;
            PG8_LDB(B1, 1, 1); PG8_STAGE(PG8_SB(1, 0), b3, voffB);
            PG8_BAR; PG8_WAIT_L(0); PG8_MMA(0, 1, At, B1); PG8_BAR;
            PG8_LDA(At, 1, 1); PG8_STAGE(PG8_SA(1, 0), a3, voffA);
            PG8_BAR; PG8_WAIT_L(0); PG8_MMA(1, 0, At, B0); PG8_BAR; PG8_SCHED;
            PG8_STAGE(PG8_SB(1, 1), b3 + hstep, voffB);
            PG8_WAIT_V(6); PG8_BAR; PG8_MMA(1, 1, At, B1); PG8_BAR;
            }
        }
        if constexpr (ALIGN_EPI) { if (wr == 0) PG8_BAR; }
        if constexpr (!Epi::AFTER_DRAIN) { E(acc, cur, wr, wc, fr, fq); S.done(cur); }
        if (!has_next) break;
#pragma unroll
        for (int a = 0; a < 2; ++a)
#pragma unroll
            for (int b = 0; b < 2; ++b)
#pragma unroll
                for (int m = 0; m < 4; ++m)
#pragma unroll
                    for (int n = 0; n < 2; ++n) acc[a][b][m][n] = (f32x4){0.f, 0.f, 0.f, 0.f};
        cur = nxt; cA = nA; cB = nB; ++ui;
        if constexpr (ALIGN_EPI) { if (wr == 1) PG8_BAR; }
    }
    PG8_WAIT_V(0);
    if constexpr (!ALIGN_EPI) { if (wr == 0) PG8_BAR; }
    PG8_BAR;
    if constexpr (Epi::AFTER_DRAIN) { E.fused(acc, cur, wr, wc, fr, fq, lds, wid, lane); S.done(cur); }
#undef PG8_SA
#undef PG8_SB
#undef PG8_STAGE
#undef PG8_LDA
#undef PG8_LDB
#undef PG8_MMA
#undef PG8_WAIT_V
#undef PG8_WAIT_L
#undef PG8_BAR
#undef PG8_SCHED
}
}

#define GAS __attribute__((address_space(1)))
#define LAS __attribute__((address_space(3)))
typedef unsigned short bf16;
typedef unsigned v4u __attribute__((ext_vector_type(4)));
typedef unsigned v2u __attribute__((ext_vector_type(2)));
typedef float f32x4 __attribute__((ext_vector_type(4)));
typedef float f32x2 __attribute__((ext_vector_type(2)));
typedef float f32x16 __attribute__((ext_vector_type(16)));
typedef short bf16x8 __attribute__((ext_vector_type(8)));
typedef short s16x4 __attribute__((ext_vector_type(4)));

#ifndef MK_N_LAUNCHES
#define MK_N_LAUNCHES 1
#endif
constexpr int NPHASE = 13;
constexpr int NWAVES = 8, NTHR = 512;

constexpr int BATCH = 8, SEQ = 2048, DM = 2048, M = BATCH * SEQ;
constexpr int HW = 1024, NH = 8, DQK = 192, DNOPE = 128, DROPE = 64, DV = 128, QLR = 512, KVLR = 256;
constexpr int INW = 3 * HW + QLR + KVLR + DROPE, INWP = 4096;
constexpr int DFF = 5632, FE = 33, FH = 64;
constexpr int NQ = NH * DQK  , NKV = NH * (DNOPE + DV)  , AW = NH * DV  ;
constexpr float EPS = 1e-6f;
constexpr int KFLEN = 4112;

constexpr size_t MiB = 1u << 20;
constexpr size_t WS_CNT = 16384, WS_CNT2 = 32768, WS_SS1 = 65536, WS_SS2 = 131072, WS_SS3 = 196608, CTL_BYTES = 262144;
constexpr size_t WS_WIN = 1 * MiB, WS_WUQ = 17 * MiB, WS_WUKV = 19 * MiB, WS_WOUT = 20 * MiB, WS_WUP = 28 * MiB, WS_WDOWN = 72 * MiB;
constexpr size_t WS_H2 = 95 * MiB;
constexpr size_t WS_ROPE = 94 * MiB;
constexpr size_t WS_XN = 96 * MiB;
constexpr size_t WS_UT = 96 * MiB, WS_X0T = 128 * MiB;
constexpr size_t WS_PROJ = 160 * MiB;
constexpr size_t WS_MIXIN = 160 * MiB, WS_O = 224 * MiB, WS_MIXED = 256 * MiB;
constexpr size_t WS_CQN = 320 * MiB, WS_CKVN = 336 * MiB, WS_KPE = 344 * MiB, WS_KF = 346 * MiB;
constexpr size_t WS_Q = 356 * MiB, WS_KV = 404 * MiB;
constexpr size_t WS_YT = 468 * MiB;
constexpr size_t WS_ACT = 160 * MiB;
constexpr size_t WS_BB = 336 * MiB;
constexpr size_t WS_F = 96 * MiB;
constexpr size_t WS_H16 = 436 * MiB;
constexpr size_t WS_END = 500 * MiB;

constexpr int LDS_BYTES = 147456;

__device__ __forceinline__ unsigned f2bf(float f) { unsigned u = __builtin_bit_cast(unsigned, f); return (u + 0x7fffu + ((u >> 16) & 1u)) >> 16; }
__device__ __forceinline__ unsigned pk2(float lo, float hi) { return f2bf(lo) | (f2bf(hi) << 16); }
__device__ __forceinline__ float bflo(unsigned w) { return __builtin_bit_cast(float, w << 16); }
__device__ __forceinline__ float bfhi(unsigned w) { return __builtin_bit_cast(float, w & 0xffff0000u); }
__device__ __forceinline__ float bf1(bf16 h) { return __builtin_bit_cast(float, (unsigned)h << 16); }
#define LDS_WAIT() asm volatile("s_waitcnt lgkmcnt(0)" ::: "memory")
__device__ __forceinline__ float wave_sum(float v) {
#pragma unroll
    for (int o = 1; o < 64; o <<= 1) v += __shfl_xor(v, o);
    return v;
}
__device__ __forceinline__ void sincos_acc(float x, float& s, float& c) {
    const double xd = (double)x; const double k = rint(xd * 0.6366197723675814);
    const float y = (float)(xd - k * 1.5707963267948966); const int q = ((int)k) & 3;
    const float y2 = y * y;
    const float sp = y + y * y2 * (-1.6666654611e-1f + y2 * (8.3321608736e-3f + y2 * (-1.9515295891e-4f)));
    const float cp = 1.f - 0.5f * y2 + y2 * y2 * (4.166664568298827e-2f + y2 * (-1.388731625493765e-3f + y2 * 2.443315711809948e-5f));
    const float s0 = (q & 1) ? cp : sp, c0 = (q & 1) ? sp : cp;
    s = (q & 2) ? -s0 : s0; c = ((q + 1) & 2) ? -c0 : c0;
}

#define XB_TMO      128
#define XB_XCNT(j)  (256  + 64 * (j))
#define XB_XSUB(j)  (1280 + 64 * (j))
#define XB_XGEN(j)  (2304 + 64 * (j))
#define XB_TOP      3328
#define XB_TOPGEN   3392
#define XCD_BAR_WORDS 3456
#define XB_SPIN_CAP (1u << 18)

__device__ __forceinline__ unsigned xb_ld(unsigned* p)              { return __hip_atomic_load(p, __ATOMIC_RELAXED, __HIP_MEMORY_SCOPE_AGENT); }
__device__ __forceinline__ unsigned xb_add(unsigned* p, unsigned v) { return __hip_atomic_fetch_add(p, v, __ATOMIC_RELAXED, __HIP_MEMORY_SCOPE_AGENT); }
__device__ __forceinline__ unsigned xb_xcc_id() { return (unsigned)__builtin_amdgcn_s_getreg((3 << 11) | 20) & 0xFu; }
#define XB_SPIN(cond, bar) do { unsigned _sp = 0; while (cond) { __builtin_amdgcn_s_sleep(1); \
    if ((++_sp & 255u) == 0u) { if (xb_ld(&(bar)[XB_TMO])) break; if (_sp > XB_SPIN_CAP) { atomicAdd(&(bar)[XB_TMO], 1u); break; } } } } while (0)

struct XcdBarrier {
    unsigned* bar; unsigned x;
    volatile LAS unsigned* st;
};

__device__ __forceinline__ XcdBarrier xcd_barrier_post(unsigned* bar, volatile LAS unsigned* st) {
    XcdBarrier b; b.bar = bar; b.x = xb_xcc_id(); b.st = st;
    if (threadIdx.x == 0) (void)xb_add(&bar[XB_XCNT(b.x)], 1u);
    return b;
}
__device__ __forceinline__ void xcd_barrier_complete(unsigned* bar, unsigned x, unsigned& nloc, unsigned& nx) {
    const unsigned G = gridDim.x * gridDim.y * gridDim.z;
    unsigned sum, cnt, mine, sp = 0u;
    for (;;) {
        sum = 0u; cnt = 0u; mine = 0u;
#pragma unroll
        for (unsigned j = 0; j < 16; ++j) { const unsigned c = xb_ld(&bar[XB_XCNT(j)]); sum += c; cnt += (c > 0u) ? 1u : 0u; mine = (j == x) ? c : mine; }
        if (sum == G) break;
        __builtin_amdgcn_s_sleep(1);
        if ((++sp & 255u) == 0u) { if (xb_ld(&bar[XB_TMO])) break; if (sp > XB_SPIN_CAP) { atomicAdd(&bar[XB_TMO], 1u); break; } }
    }
    nloc = mine > 0u ? mine : 1u; nx = cnt > 0u ? cnt : 1u;
}

__device__ __forceinline__ void xcd_barrier(const XcdBarrier& b) {
    asm volatile("s_waitcnt vmcnt(0)" ::: "memory");
    __syncthreads();
    if (threadIdx.x == 0) {
        unsigned* bar = b.bar;
        __builtin_amdgcn_s_waitcnt(0);
        unsigned nloc = b.st[0], nx = b.st[1];
        if (nloc == 0u) { xcd_barrier_complete(bar, b.x, nloc, nx); b.st[0] = nloc; b.st[1] = nx; }
        const unsigned old = xb_add(&bar[XB_XSUB(b.x)], 1u);
        const unsigned gen = old / nloc;
        if (old + 1u == (gen + 1u) * nloc) {
            __builtin_amdgcn_fence(__ATOMIC_RELEASE, "agent");
            asm volatile("s_waitcnt vmcnt(0)" ::: "memory");
            const unsigned og = xb_add(&bar[XB_TOP], 1u);
            const unsigned tg = og / nx;
            if (og + 1u == (tg + 1u) * nx) xb_add(&bar[XB_TOPGEN], 1u);
            else XB_SPIN(xb_ld(&bar[XB_TOPGEN]) == tg, bar);
            __builtin_amdgcn_fence(__ATOMIC_ACQUIRE, "agent");
            asm volatile("s_waitcnt vmcnt(0)" ::: "memory");
        } else {
            XB_SPIN(xb_ld(&bar[XB_TOPGEN]) == gen, bar);
            __builtin_amdgcn_fence(__ATOMIC_ACQUIRE, "agent");
            asm volatile("s_waitcnt vmcnt(0)" ::: "memory");
        }
    }
    __syncthreads();
}

struct Frame {
    LAS unsigned char* lds; char* ldsg;
    int tid, lane, wave, vcu, G;
    const float* in[27]; float* out; unsigned char* ws;
};

__device__ __forceinline__ void p0_transpose_item(const float* W, int K, int N, bf16* WT, int k0, int n0, int drow0, LAS float* scr, int lane, const float* kscale) {
    f32x4 v[8];
#pragma unroll
    for (int i = 0; i < 8; ++i) v[i] = __builtin_nontemporal_load((const f32x4*)(W + (size_t)(k0 + (lane >> 3) + 8 * i) * N + n0 + (lane & 7) * 4));
#pragma unroll
    for (int i = 0; i < 8; ++i) { LAS float* d = scr + ((lane >> 3) + 8 * i) * 33 + (lane & 7) * 4; d[0] = v[i].x; d[1] = v[i].y; d[2] = v[i].z; d[3] = v[i].w; }
    LDS_WAIT(); asm volatile("" ::: "memory");
    const int c = lane & 7;
    float ks[8];
#pragma unroll
    for (int e = 0; e < 8; ++e) ks[e] = kscale ? kscale[k0 + 8 * c + e] : 1.f;
#pragma unroll
    for (int j = 0; j < 4; ++j) { const int n = (lane >> 3) + 8 * j; const LAS float* s = scr + (8 * c) * 33 + n;
        v4u o; o.x = pk2(s[0 * 33] * ks[0], s[1 * 33] * ks[1]); o.y = pk2(s[2 * 33] * ks[2], s[3 * 33] * ks[3]); o.z = pk2(s[4 * 33] * ks[4], s[5 * 33] * ks[5]); o.w = pk2(s[6 * 33] * ks[6], s[7 * 33] * ks[7]);
        if (kscale || K == DFF || N == DM) __builtin_nontemporal_store(o, (v4u*)(WT + (size_t)(drow0 + n) * K + k0 + 8 * c));
        else *(GAS v4u*)(WT + (size_t)(drow0 + n) * K + k0 + 8 * c) = o; }
    LDS_WAIT(); asm volatile("" ::: "memory");
}
__device__ __forceinline__ void p0_transpose_mat(Frame& F, const float* W, int K, int N, bf16* WT, bool upmap, const float* kscale = nullptr) {
    LAS float* scr = (LAS float*)(F.lds + F.wave * 16384);
    const int gw = F.vcu * NWAVES + F.wave, NGW = F.G * NWAVES; const int nblk = N / 32, nitems = (K / 64) * nblk;
    for (int it = gw; it < nitems; it += NGW) { const int kb = it / nblk, nb = it % nblk, n0 = 32 * nb;
        int drow0 = n0;
        if (upmap) drow0 = (n0 < DFF) ? (n0 >> 7) * 256 + (n0 & 127) : ((n0 - DFF) >> 7) * 256 + 128 + ((n0 - DFF) & 127);
        p0_transpose_item(W, K, N, WT, 64 * kb, n0, drow0, scr, F.lane, kscale); }
}
__device__ __forceinline__ void rms_row_to_bf16(const float* xrow, const float* gain, bf16* orow, int lane) {
    f32x4 v[8]; float s = 0.f;
#pragma unroll
    for (int j = 0; j < 8; ++j) { v[j] = __builtin_nontemporal_load((const f32x4*)(xrow + 4 * (lane + 64 * j))); s += (v[j].x * v[j].x + v[j].y * v[j].y) + (v[j].z * v[j].z + v[j].w * v[j].w); }
    const float r = 1.f / sqrtf(wave_sum(s) * (1.f / DM) + EPS);
#pragma unroll
    for (int j = 0; j < 8; ++j) { const f32x4 g = *(const f32x4*)(gain + 4 * (lane + 64 * j));
        v2u o; o.x = pk2(v[j].x * r * g.x, v[j].y * r * g.y); o.y = pk2(v[j].z * r * g.z, v[j].w * r * g.w);
        *(v2u*)(orow + 4 * (lane + 64 * j)) = o; }
}
__device__ __forceinline__ void p0_filter_hidden(Frame& F) {
    LAS float* Z = (LAS float*)F.lds;
    LAS float* H1 = Z + 8 * 33;
    const float *w1 = F.in[5], *b1 = F.in[6], *fr1 = F.in[7], *w2 = F.in[8], *b2 = F.in[9], *fr2 = F.in[10];
    float* H2G = (float*)(F.ws + WS_H2);
    const int tid = F.tid;
    for (int unit = F.vcu; unit < SEQ / 8; unit += F.G) {
        const int l0 = unit * 8;
        __syncthreads();
        if (tid < 8 * 33) { const int l = l0 + tid / 33, f = tid % 33; float v;
            if (f == 0) v = (float)l * (1.0f / (float)(SEQ - 1));
            else { const int j = (f - 1) & 15; const float w = 6.283185307179586f * (float)l / (float)SEQ; const float fj = 1e-4f + (float)j * ((15.0f - 1e-4f) / 15.0f);
                float s, c; sincos_acc(w * fj, s, c); v = (f <= 16) ? c : -s; }
            Z[tid] = v; }
        __syncthreads();
        const int l = tid >> 6, k = tid & 63;
        { float a = b1[k];
#pragma unroll
          for (int f = 0; f < FE; ++f) a += Z[l * 33 + f] * w1[f * FH + k];
          float s, c; sincos_acc(fr1[k] * a, s, c); H1[l * 65 + k] = s; }
        __syncthreads();
        { float a = b2[k];
#pragma unroll 16
          for (int j = 0; j < FH; ++j) a += H1[l * 65 + j] * w2[j * FH + k];
          float s, c; sincos_acc(fr2[k] * a, s, c); H2G[(size_t)(l0 + l) * FH + k] = s; }
    }
    __syncthreads();
}
__device__ __forceinline__ void p2_filter_out(Frame& F) {
    LAS float* H2 = (LAS float*)F.lds;
    LAS float* W3 = H2 + 64 * 65 + 12;
    const float* w3 = F.in[11]; const float* H2G = (const float*)(F.ws + WS_H2);
    bf16* KF = (bf16*)(F.ws + WS_KF);
    const int tid = F.tid;
    for (int i = F.vcu * NTHR + tid; i < HW * 17; i += F.G * NTHR) KF[(size_t)(i / 17) * KFLEN + (i % 17)] = 0;
    for (int unit = F.vcu; unit < 32 * 16; unit += F.G) {
        const int l0 = (unit >> 4) * 64, n0 = (unit & 15) * 128;
        __syncthreads();
#pragma unroll
        for (int i = 0; i < 2; ++i) { const int id = tid + NTHR * i; const int l = id >> 4, k4 = (id & 15) * 4; const f32x4 v = *(const f32x4*)(H2G + (size_t)(l0 + l) * FH + k4);
            LAS float* d = H2 + l * 65 + k4; d[0] = v.x; d[1] = v.y; d[2] = v.z; d[3] = v.w; }
#pragma unroll
        for (int i = 0; i < 4; ++i) { const int id = tid + NTHR * i; const int k = id >> 5, c4 = (id & 31) * 4;
            *(LAS f32x4*)(W3 + k * 128 + c4) = *(const f32x4*)(w3 + (size_t)k * (2 * HW) + n0 + c4); }
        __syncthreads();
        { const int l = tid & 63, ng = __builtin_amdgcn_readfirstlane(tid >> 6); const int nb = n0 + ng * 16;
          float acc[16];
#pragma unroll
          for (int i = 0; i < 16; ++i) acc[i] = 0.f;
#pragma unroll 4
          for (int k = 0; k < FH; ++k) { const float h = H2[l * 65 + k]; const LAS f32x4* wr = (const LAS f32x4*)(W3 + k * 128 + ng * 16);
#pragma unroll
              for (int q = 0; q < 4; ++q) { const f32x4 wv = wr[q]; acc[4 * q] += h * wv.x; acc[4 * q + 1] += h * wv.y; acc[4 * q + 2] += h * wv.z; acc[4 * q + 3] += h * wv.w; } }
          const int lg = l0 + l; const float tl = (float)lg * (1.0f / (float)(SEQ - 1));
          const float mind = -3.0701134573253945f, maxd = -15.350567286626973f;
#pragma unroll
          for (int i = 0; i < 16; ++i) { const int n = nb + i, dir = n >> 10, c = n & 1023;
              const float delta = fabsf(mind + (float)c * ((maxd - mind) / 1023.0f));
              const float win = __expf(-tl * delta) + 0.05f; const float v = acc[i] * win;
              if (dir == 0) KF[(size_t)c * KFLEN + 16 + 2048 - lg] = (bf16)f2bf(v);
              else if (lg > 0) KF[(size_t)c * KFLEN + 16 + 2048 + lg] = (bf16)f2bf(v); }
        }
    }
    __syncthreads();
}
__device__ __forceinline__ void p0_prologue(Frame& F) {
    unsigned char* ws = F.ws;
    p0_transpose_mat(F, F.in[2], DM, INW, (bf16*)(ws + WS_WIN), false);
    p0_transpose_mat(F, F.in[14], QLR, NQ, (bf16*)(ws + WS_WUQ), false);
    p0_transpose_mat(F, F.in[16], KVLR, NKV, (bf16*)(ws + WS_WUKV), false);
    p0_transpose_mat(F, F.in[19], DM, DM, (bf16*)(ws + WS_WOUT), false);
    p0_transpose_mat(F, F.in[22], DM, 2 * DFF, (bf16*)(ws + WS_WUP), true, F.in[21]);
    p0_transpose_mat(F, F.in[25], DFF, DM, (bf16*)(ws + WS_WDOWN), false);
    const int gw = F.vcu * NWAVES + F.wave, NGW = F.G * NWAVES;
    bf16* XN = (bf16*)(ws + WS_XN);
    for (int m = gw; m < M; m += NGW) rms_row_to_bf16(F.in[0] + (size_t)m * DM, F.in[1], XN + (size_t)m * DM, F.lane);
}
__device__ __forceinline__ void p0_pre(Frame& F) {
    f32x2* ROPE = (f32x2*)(F.ws + WS_ROPE);
    for (int i = F.vcu * NTHR + F.tid; i < SEQ * 32; i += F.G * NTHR) { const int s = i >> 5, j = i & 31;
        const float invf = 1.0f / powf(10000.0f, (float)(2 * j) / 64.0f); const float ang = (float)s * invf;
        float sn, cs; sincos_acc(ang, sn, cs); ROPE[i] = (f32x2){cs, sn}; }
    p0_filter_hidden(F);
}

__device__ __forceinline__ void p2_hyena_prep(Frame& F) {
    constexpr int TP = 72;
    LAS bf16* TB = (LAS bf16*)F.lds;
    const bf16* PROJ = (const bf16*)(F.ws + WS_PROJ); bf16* UT = (bf16*)(F.ws + WS_UT); bf16* X0T = (bf16*)(F.ws + WS_X0T);
    const float* cw = F.in[3]; const float* cb = F.in[4];
    const int tid = F.tid, ch = tid & 7, sl = tid >> 3;
    int it = 0;
    for (int unit = F.vcu; unit < BATCH * 32 * 16; unit += F.G, ++it) {
        const int ct = unit & 15, st = (unit >> 4) & 31, b = unit >> 9; const int c0 = ct * 64 + ch * 8, s = st * 64 + sl;
        v4u w[3][3];
#pragma unroll
        for (int a = 0; a < 3; ++a)
#pragma unroll
            for (int j = 0; j < 3; ++j) { const int ss = s - 1 + j; w[a][j] = (v4u){0u, 0u, 0u, 0u};
                if (ss >= 0 && ss < SEQ) w[a][j] = *(const v4u*)(PROJ + (size_t)(b * SEQ + ss) * INWP + a * HW + c0); }
        float val[3][8];
#pragma unroll
        for (int a = 0; a < 3; ++a) { const float* wp = cw + a * HW + c0;
            const f32x4 k0a = *(const f32x4*)(wp), k0b = *(const f32x4*)(wp + 4), k1a = *(const f32x4*)(wp + 3 * HW), k1b = *(const f32x4*)(wp + 3 * HW + 4);
            const f32x4 k2a = *(const f32x4*)(wp + 6 * HW), k2b = *(const f32x4*)(wp + 6 * HW + 4), bba = *(const f32x4*)(cb + a * HW + c0), bbb = *(const f32x4*)(cb + a * HW + c0 + 4);
            const float k0[8] = {k0a.x, k0a.y, k0a.z, k0a.w, k0b.x, k0b.y, k0b.z, k0b.w}, k1[8] = {k1a.x, k1a.y, k1a.z, k1a.w, k1b.x, k1b.y, k1b.z, k1b.w};
            const float k2[8] = {k2a.x, k2a.y, k2a.z, k2a.w, k2b.x, k2b.y, k2b.z, k2b.w}, bb[8] = {bba.x, bba.y, bba.z, bba.w, bbb.x, bbb.y, bbb.z, bbb.w};
            const unsigned r0[4] = {w[a][0].x, w[a][0].y, w[a][0].z, w[a][0].w}, r1[4] = {w[a][1].x, w[a][1].y, w[a][1].z, w[a][1].w}, r2[4] = {w[a][2].x, w[a][2].y, w[a][2].z, w[a][2].w};
#pragma unroll
            for (int k = 0; k < 4; ++k) {
                val[a][2 * k] = k0[2 * k] * bflo(r0[k]) + k1[2 * k] * bflo(r1[k]) + k2[2 * k] * bflo(r2[k]) + bb[2 * k];
                val[a][2 * k + 1] = k0[2 * k + 1] * bfhi(r0[k]) + k1[2 * k + 1] * bfhi(r1[k]) + k2[2 * k + 1] * bfhi(r2[k]) + bb[2 * k + 1]; } }
        LAS bf16* Tu = TB + (it & 1) * (2 * 64 * TP); LAS bf16* Tx = Tu + 64 * TP;
#pragma unroll
        for (int e = 0; e < 8; ++e) { Tu[(ch * 8 + e) * TP + sl] = (bf16)f2bf(val[1][e] * val[2][e]); Tx[(ch * 8 + e) * TP + sl] = (bf16)f2bf(val[0][e]); }
        __syncthreads();
        { const int c = tid >> 3, pc = tid & 7; const size_t o = ((size_t)(ct * 64 + c) * BATCH + b) * SEQ + st * 64 + pc * 8;
          *(v4u*)(UT + o) = *(const LAS v4u*)(Tu + c * TP + pc * 8); *(v4u*)(X0T + o) = *(const LAS v4u*)(Tx + c * TP + pc * 8); }
    }
    __syncthreads();
}
__device__ __forceinline__ void p2_mla_prep(Frame& F) {
    const bf16* PROJ = (const bf16*)(F.ws + WS_PROJ); bf16* CQN = (bf16*)(F.ws + WS_CQN); bf16* CKVN = (bf16*)(F.ws + WS_CKVN); bf16* KPE = (bf16*)(F.ws + WS_KPE);
    const f32x2* ROPE = (const f32x2*)(F.ws + WS_ROPE);
    const float* gq = F.in[13]; const float* gkv = F.in[15];
    const int gw = F.vcu * NWAVES + F.wave, NGW = F.G * NWAVES, lane = F.lane;
    const f32x4 gq0 = *(const f32x4*)(gq + 8 * lane), gq1 = *(const f32x4*)(gq + 8 * lane + 4), gk0 = *(const f32x4*)(gkv + 4 * lane);
    constexpr int UR = 2;
    for (int m0 = gw; m0 < M; m0 += NGW * UR) {
        v4u wq[UR]; v2u wk[UR]; bf16 xp[UR]; f32x2 cs[UR];
#pragma unroll
        for (int u = 0; u < UR; ++u) { const int m = m0 + u * NGW; const bf16* row = PROJ + (size_t)m * INWP;
            wq[u] = __builtin_nontemporal_load((const v4u*)(row + 3 * HW + 8 * lane)); wk[u] = __builtin_nontemporal_load((const v2u*)(row + 3 * HW + QLR + 4 * lane));
            xp[u] = row[3 * HW + QLR + KVLR + lane]; cs[u] = ROPE[(m & (SEQ - 1)) * 32 + (lane & 31)]; }
#pragma unroll
        for (int u = 0; u < UR; ++u) { const int m = m0 + u * NGW;
            { const v4u w = wq[u];
              float v[8] = {bflo(w.x), bfhi(w.x), bflo(w.y), bfhi(w.y), bflo(w.z), bfhi(w.z), bflo(w.w), bfhi(w.w)}; float s = 0.f;
#pragma unroll
              for (int i = 0; i < 8; ++i) s += v[i] * v[i];
              const float r = 1.f / sqrtf(wave_sum(s) * (1.f / QLR) + EPS);
              v4u o; o.x = pk2(v[0] * r * gq0.x, v[1] * r * gq0.y); o.y = pk2(v[2] * r * gq0.z, v[3] * r * gq0.w); o.z = pk2(v[4] * r * gq1.x, v[5] * r * gq1.y); o.w = pk2(v[6] * r * gq1.z, v[7] * r * gq1.w);
              *(v4u*)(CQN + (size_t)m * QLR + 8 * lane) = o; }
            { const v2u w = wk[u];
              float v[4] = {bflo(w.x), bfhi(w.x), bflo(w.y), bfhi(w.y)}; float s = (v[0] * v[0] + v[1] * v[1]) + (v[2] * v[2] + v[3] * v[3]);
              const float r = 1.f / sqrtf(wave_sum(s) * (1.f / KVLR) + EPS);
              v2u o; o.x = pk2(v[0] * r * gk0.x, v[1] * r * gk0.y); o.y = pk2(v[2] * r * gk0.z, v[3] * r * gk0.w);
              *(v2u*)(CKVN + (size_t)m * KVLR + 4 * lane) = o; }
            { const float x = bf1(xp[u]); const float p = __shfl_xor(x, 32);
              const float o = x * cs[u].x + ((lane < 32) ? -p : p) * cs[u].y;
              KPE[(size_t)m * DROPE + lane] = (bf16)f2bf(o); } }
    }
}

constexpr int US_PITCH = 2120;
constexpr int KFP = 4120;
__device__ __forceinline__ bf16x8 hy_afrag(const LAS bf16* FC, int a, int i, int quad) {
    const int sh = i & 7;
    return *(const LAS bf16x8*)(FC + sh * KFP + (16 + 2048 - 32 * a + quad * 8 - (i - sh)));
}
__device__ __forceinline__ void p4_longconv(Frame& F) {
    LAS bf16* FL = (LAS bf16*)F.lds;
    LAS bf16* US = (LAS bf16*)(F.lds + 66048);
    const bf16* KF = (const bf16*)(F.ws + WS_KF); const bf16* UT = (const bf16*)(F.ws + WS_UT); const bf16* X0T = (const bf16*)(F.ws + WS_X0T); bf16* YT = (bf16*)(F.ws + WS_YT);
    const float* hbias = F.in[12];
    const int tid = F.tid, lane = F.lane, w = F.wave, i16 = lane & 15, quad = lane >> 4, batch = lane & 7, g = (lane >> 3) & 1;
    for (int c = F.vcu; c < HW; c += F.G) {
        __syncthreads();
        { v4u kf[9], us[4];
#pragma unroll
          for (int i = 0; i < 9; ++i) { const int id = tid + NTHR * i; const int sh = id & 7, ck = (id >> 3) + 1;
              kf[i] = (v4u){0u, 0u, 0u, 0u}; if (id < 8 * 513) __builtin_memcpy(&kf[i], (const char*)(KF + (size_t)c * KFLEN + ck * 8 - sh), 16); }
#pragma unroll
          for (int i = 0; i < 4; ++i) { const int id = tid + NTHR * i; const int b = id >> 8, ch = id & 255;
              us[i] = __builtin_nontemporal_load((const v4u*)(UT + ((size_t)c * BATCH + b) * SEQ + ch * 8)); }
#pragma unroll
          for (int i = 0; i < 9; ++i) { const int id = tid + NTHR * i; const int sh = id & 7, ck = (id >> 3) + 1; if (id < 8 * 513) *(LAS v4u*)(FL + sh * KFP + ck * 8) = kf[i]; }
#pragma unroll
          for (int i = 0; i < 4; ++i) { const int id = tid + NTHR * i; const int b = id >> 8, ch = id & 255; *(LAS v4u*)(US + b * US_PITCH + 32 + ch * 8) = us[i]; } }
        for (int id = tid; id < 8 * 9; id += NTHR) { const int b = id / 9, ch = id % 9;
            const int off = (ch < 4) ? ch * 8 : 32 + 2048 + (ch - 4) * 8; *(LAS v4u*)(US + b * US_PITCH + off) = (v4u){0u, 0u, 0u, 0u}; }
        __syncthreads();
        f32x4 acc[8]; bf16x8 ar[8];
#pragma unroll
        for (int p = 0; p < 8; ++p) acc[p] = (f32x4){0.f, 0.f, 0.f, 0.f};
#pragma unroll
        for (int p = 0; p < 8; ++p) ar[p] = hy_afrag(FL, 8 * w + p + 1, i16, quad);
        const LAS bf16* ub = US + batch * US_PITCH + 32 + 16 * g + quad * 8;
        bf16x8 bcur = *(const LAS bf16x8*)(ub - 32);
        for (int J = 0; J < 9; ++J) {
#pragma unroll
            for (int jj8 = 0; jj8 < 8; ++jj8) {
                const int jj = J * 8 + jj8;
                if (jj < 65) {
                    const int j = jj - 1; const bool more = (jj + 1 < 65);
                    bf16x8 bnext = bcur, anext = ar[(7 - jj8) & 7];
                    if (more) { bnext = *(const LAS bf16x8*)(ub + 32 * (j + 1)); anext = hy_afrag(FL, 8 * w - (j + 1), i16, quad); }
#pragma unroll
                    for (int p = 0; p < 8; ++p) acc[p] = __builtin_amdgcn_mfma_f32_16x16x32_bf16(ar[(p - jj8) & 7], bcur, acc[p], 0, 0, 0);
                    ar[(7 - jj8) & 7] = anext; bcur = bnext;
                }
            }
        }
        const float hb = hbias[c];
#pragma unroll
        for (int p = 0; p < 8; ++p) { const int t = 32 * (8 * w + p) + 16 * g + quad * 4;
            const size_t o = ((size_t)c * BATCH + batch) * SEQ + t;
            const v2u xw = __builtin_nontemporal_load((const v2u*)(X0T + o)); const v2u uw = *(const LAS v2u*)(US + batch * US_PITCH + 32 + t);
            const float y0 = bflo(xw.x) * (acc[p][0] + hb * bflo(uw.x)), y1 = bfhi(xw.x) * (acc[p][1] + hb * bfhi(uw.x));
            const float y2 = bflo(xw.y) * (acc[p][2] + hb * bflo(uw.y)), y3 = bfhi(xw.y) * (acc[p][3] + hb * bfhi(uw.y));
            v2u ov; ov.x = pk2(y0, y1); ov.y = pk2(y2, y3); *(v2u*)(YT + o) = ov; }
    }
    __syncthreads();
}

namespace att {
constexpr int QBLK = 32, KVBLK = 64;
constexpr float SCALE = 0.07216878364870322f;
constexpr float THR = 8.f;
constexpr int SHM_V = KVBLK * DV * 2  , SHM_K = KVBLK * DQK * 2  , SHM_ATTN = 2 * SHM_V + 2 * SHM_K + NWAVES * 64 * 4;
#define KSWZ(row, colB) ((row) * 384 + ((colB) ^ ((((row) >> 1) & 7) << 4)))
#define SBAR() __builtin_amdgcn_sched_barrier(0)
__device__ __forceinline__ int crow(int r, int hi) { return (r & 3) + 8 * (r >> 2) + 4 * hi; }
__device__ __forceinline__ unsigned cvtpk(float lo, float hi) { unsigned r; asm volatile("v_cvt_pk_bf16_f32 %0, %1, %2" : "=v"(r) : "v"(lo), "v"(hi)); return r; }
__device__ __forceinline__ void partialSM(f32x16& p0, f32x16& p1, float& m_reg, float& mn, float& alpha) {
  constexpr float C = SCALE * 1.4426950408889634f;
  float pmax = p0[0];
#pragma unroll
  for (int r = 1; r < 16; ++r) pmax = fmaxf(pmax, p0[r]);
#pragma unroll
  for (int r = 0; r < 16; ++r) pmax = fmaxf(pmax, p1[r]);
  { auto rr = __builtin_amdgcn_permlane32_swap(__float_as_uint(pmax), __float_as_uint(pmax), false, false);
    pmax = fmaxf(__uint_as_float(rr[0]), __uint_as_float(rr[1])); }
  if (__builtin_expect(__all(pmax - m_reg <= THR / SCALE), 1)) { mn = m_reg; alpha = 1.f; }
  else { mn = fmaxf(m_reg, pmax); alpha = __builtin_amdgcn_exp2f((m_reg - mn) * C); m_reg = mn; }
  float mnC = -mn * C;
#pragma unroll
  for (int r = 0; r < 16; ++r) p0[r] = fmaf(p0[r], C, mnC);
#pragma unroll
  for (int r = 0; r < 16; ++r) p1[r] = fmaf(p1[r], C, mnC);
#pragma unroll
  for (int r = 0; r < 16; ++r) p0[r] = __builtin_amdgcn_exp2f(p0[r]);
}
__device__ __forceinline__ void finishSM(f32x16& p0, f32x16& p1, float alpha, float& l_reg, bf16x8& pa0, bf16x8& pa1, bf16x8& pa2, bf16x8& pa3) {
#pragma unroll
  for (int r = 0; r < 16; ++r) p1[r] = __builtin_amdgcn_exp2f(p1[r]);
  float ps = 0;
#pragma unroll
  for (int r = 0; r < 16; ++r) ps += p0[r];
#pragma unroll
  for (int r = 0; r < 16; ++r) ps += p1[r];
  { auto rr = __builtin_amdgcn_permlane32_swap(__float_as_uint(ps), __float_as_uint(ps), false, false);
    ps = __uint_as_float(rr[0]) + __uint_as_float(rr[1]); }
  l_reg = l_reg * alpha + ps;
#define PK4(P, BASE, OUT) do { unsigned a0 = cvtpk(P[BASE + 0], P[BASE + 1]), a1 = cvtpk(P[BASE + 2], P[BASE + 3]);   \
    unsigned b0 = cvtpk(P[BASE + 4], P[BASE + 5]), b1 = cvtpk(P[BASE + 6], P[BASE + 7]);                              \
    auto r0 = __builtin_amdgcn_permlane32_swap(a0, b0, false, false); auto r1 = __builtin_amdgcn_permlane32_swap(a1, b1, false, false); \
    v4u w = {r0[0], r1[0], r0[1], r1[1]}; OUT = __builtin_bit_cast(bf16x8, w); } while (0)
  PK4(p0, 0, pa0); PK4(p0, 8, pa1); PK4(p1, 0, pa2); PK4(p1, 8, pa3);
#undef PK4
}
__device__ __forceinline__ void qkt(f32x16& p0, f32x16& p1, const char* Ks, const bf16x8* qr, int r32, int hi) {
  p0 = f32x16{}; p1 = f32x16{};
#pragma unroll
  for (int d0 = 0; d0 < 12; ++d0) { int cb = (d0 * 16 + hi * 8) * 2;
    bf16x8 b0 = *reinterpret_cast<const bf16x8*>(Ks + KSWZ(r32, cb));
    bf16x8 b1 = *reinterpret_cast<const bf16x8*>(Ks + KSWZ(32 + r32, cb));
    p0 = __builtin_amdgcn_mfma_f32_32x32x16_bf16(b0, qr[d0], p0, 0, 0, 0);
    p1 = __builtin_amdgcn_mfma_f32_32x32x16_bf16(b1, qr[d0], p1, 0, 0, 0); }
}
__device__ __forceinline__ int v_st(int k, int c) { const int kk = (k & ~0xC) | ((k & 4) << 1) | ((k & 8) >> 1); return ((kk >> 3) * 4 + (c >> 5)) * 512 + ((kk & 7) * 32 + (c & 31)) * 2; }
__device__ __forceinline__ int v_rd_base(int lane) { return ((lane & 3) << 3) | (((lane >> 2) & 3) << 6) | (((lane >> 4) & 1) << 5) | (((lane >> 5) & 1) << 8); }
constexpr int v_rd_off(int d0, int ks, int half) { return d0 * 512 + ks * 4096 + half * 2048; }
template <int OFF> __device__ __forceinline__ s16x4 tr_read(int vb) {
  s16x4 r; asm volatile("ds_read_b64_tr_b16 %0, %1 offset:%2" : "=&v"(r) : "v"(vb), "i"(OFF) : "memory"); return r;
}
template <int D0> __device__ __forceinline__ void pv_one(f32x16& od, int vb, bf16x8 pa0, bf16x8 pa1, bf16x8 pa2, bf16x8 pa3) {
  const s16x4 l0 = tr_read<v_rd_off(D0, 0, 0)>(vb), h0 = tr_read<v_rd_off(D0, 0, 1)>(vb), l1 = tr_read<v_rd_off(D0, 1, 0)>(vb), h1 = tr_read<v_rd_off(D0, 1, 1)>(vb);
  const s16x4 l2 = tr_read<v_rd_off(D0, 2, 0)>(vb), h2 = tr_read<v_rd_off(D0, 2, 1)>(vb), l3 = tr_read<v_rd_off(D0, 3, 0)>(vb), h3 = tr_read<v_rd_off(D0, 3, 1)>(vb);
  asm volatile("s_waitcnt lgkmcnt(0)" ::: "memory"); SBAR();
#define PK(L, H) (bf16x8){L[0], L[1], L[2], L[3], H[0], H[1], H[2], H[3]}
  od = __builtin_amdgcn_mfma_f32_32x32x16_bf16(pa0, PK(l0, h0), od, 0, 0, 0);
  od = __builtin_amdgcn_mfma_f32_32x32x16_bf16(pa1, PK(l1, h1), od, 0, 0, 0);
  od = __builtin_amdgcn_mfma_f32_32x32x16_bf16(pa2, PK(l2, h2), od, 0, 0, 0);
  od = __builtin_amdgcn_mfma_f32_32x32x16_bf16(pa3, PK(l3, h3), od, 0, 0, 0);
#undef PK
}
__device__ __forceinline__ void pv_d0(f32x16* o, int vb, bf16x8 pa0, bf16x8 pa1, bf16x8 pa2, bf16x8 pa3) {
  pv_one<0>(o[0], vb, pa0, pa1, pa2, pa3); pv_one<1>(o[1], vb, pa0, pa1, pa2, pa3); pv_one<2>(o[2], vb, pa0, pa1, pa2, pa3); pv_one<3>(o[3], vb, pa0, pa1, pa2, pa3);
}
__device__ __forceinline__ void attn_unit(const bf16* __restrict__ Qb, const bf16* __restrict__ KVh, const bf16* __restrict__ KPb, bf16* __restrict__ Ob, const f32x2* __restrict__ rope, char* lds) {
  const int tid = threadIdx.x, wid = tid >> 6, lane = tid & 63, r32 = lane & 31, hi = lane >> 5;
  char* V_lds = lds; char* K_lds = lds + 2 * SHM_V;
  float* wsf = (float*)(lds + 2 * SHM_V + 2 * SHM_K) + wid * 64; float* li_l = wsf; float* al_l = wsf + 32;
  float m_reg = -1e30f, l_reg = 0; f32x16 o[4] = {}; bf16x8 qr[12];
  { const bf16* Qw = Qb + (size_t)(wid * QBLK + r32) * NQ + hi * 8;
#pragma unroll
    for (int d0 = 0; d0 < 8; ++d0) qr[d0] = *reinterpret_cast<const bf16x8*>(Qw + d0 * 16);
    const f32x2* rp = rope + (size_t)(wid * QBLK + r32) * 32 + hi * 8;
#pragma unroll
    for (int pp = 0; pp < 2; ++pp) {
      const v4u wa = *reinterpret_cast<const v4u*>(Qw + 128 + 16 * pp), wb = *reinterpret_cast<const v4u*>(Qw + 128 + 32 + 16 * pp);
      const unsigned a[4] = {wa.x, wa.y, wa.z, wa.w}, b[4] = {wb.x, wb.y, wb.z, wb.w}; unsigned oa[4], ob[4];
#pragma unroll
      for (int k = 0; k < 4; ++k) { const f32x2 cs0 = rp[16 * pp + 2 * k], cs1 = rp[16 * pp + 2 * k + 1];
        const float x0 = bflo(a[k]), x1 = bfhi(a[k]), y0 = bflo(b[k]), y1 = bfhi(b[k]);
        oa[k] = cvtpk(x0 * cs0.x - y0 * cs0.y, x1 * cs1.x - y1 * cs1.y);
        ob[k] = cvtpk(y0 * cs0.x + x0 * cs0.y, y1 * cs1.x + x1 * cs1.y); }
      qr[8 + pp] = __builtin_bit_cast(bf16x8, (v4u){oa[0], oa[1], oa[2], oa[3]}); qr[10 + pp] = __builtin_bit_cast(bf16x8, (v4u){ob[0], ob[1], ob[2], ob[3]}); }
  }
  const int sr = tid >> 4, sc = (tid & 15) * 8, vst0 = v_st(sr, sc), vst1 = v_st(32 + sr, sc);
  const int pr = tid >> 3, pc = (tid & 7) * 8;
  const int vb0 = (int)(uintptr_t)V_lds + v_rd_base(lane);
  const bf16* gkv = KVh + (size_t)sr * NKV + sc; const bf16* gkp = KPb + (size_t)pr * DROPE + pc;
  const int kst0 = KSWZ(sr, sc * 2), kst1 = KSWZ(32 + sr, sc * 2), kst2 = KSWZ(pr, 256 + pc * 2);
  bf16x8 vs0, vs1, ks0, ks1, ks2;
#define SLOAD(k0) do { const bf16* g_ = gkv + (size_t)(k0) * NKV; ks0 = *reinterpret_cast<const bf16x8*>(g_); vs0 = *reinterpret_cast<const bf16x8*>(g_ + 128); \
    ks1 = *reinterpret_cast<const bf16x8*>(g_ + 32 * NKV); vs1 = *reinterpret_cast<const bf16x8*>(g_ + 32 * NKV + 128); ks2 = *reinterpret_cast<const bf16x8*>(gkp + (size_t)(k0) * DROPE); } while (0)
#define SWRITE(b) do { *(bf16x8*)(V_lds + (b) * SHM_V + vst0) = vs0; *(bf16x8*)(V_lds + (b) * SHM_V + vst1) = vs1; \
    *(bf16x8*)(K_lds + (b) * SHM_K + kst0) = ks0; *(bf16x8*)(K_lds + (b) * SHM_K + kst1) = ks1; *(bf16x8*)(K_lds + (b) * SHM_K + kst2) = ks2; } while (0)
#define SWAIT() asm volatile("s_waitcnt vmcnt(0)" ::: "memory")
#define RESC(a) do { if (__any((a) < 1.f)) { if (hi == 0) al_l[r32] = (a); asm volatile("s_waitcnt lgkmcnt(0)" ::: "memory"); \
    _Pragma("unroll") for (int d = 0; d < 4; ++d) _Pragma("unroll") for (int r = 0; r < 16; ++r) o[d][r] *= al_l[crow(r, hi)]; } } while (0)
  f32x16 p0, p1; float mn, al; bf16x8 pa0, pa1, pa2, pa3; constexpr int NT = SEQ / KVBLK;
  SLOAD(0); SWAIT(); SWRITE(0); __syncthreads();
  for (int j = 0; j < NT; ++j) {
    const int bsel = j & 1;
    SBAR(); qkt(p0, p1, K_lds + bsel * SHM_K, qr, r32, hi); SBAR();
    if (j + 1 < NT) SLOAD((j + 1) * KVBLK);
    SBAR();
    partialSM(p0, p1, m_reg, mn, al); RESC(al);
    finishSM(p0, p1, al, l_reg, pa0, pa1, pa2, pa3); SBAR();
    pv_d0(o, vb0 + bsel * SHM_V, pa0, pa1, pa2, pa3);
    if (j + 1 < NT) { SWAIT(); SWRITE(bsel ^ 1); }
    __syncthreads();
  }
  if (hi == 0) li_l[r32] = l_reg; asm volatile("s_waitcnt lgkmcnt(0)" ::: "memory");
  float rli[16];
#pragma unroll
  for (int r = 0; r < 16; ++r) rli[r] = __builtin_amdgcn_rcpf(li_l[crow(r, hi)]);
  bf16* Ow = Ob + (size_t)(wid * QBLK) * AW;
#pragma unroll
  for (int r = 0; r < 16; ++r) { int orow = crow(r, hi);
#pragma unroll
    for (int d0 = 0; d0 < 4; ++d0) Ow[(size_t)orow * AW + d0 * 32 + r32] = (bf16)f2bf(o[d0][r] * rli[r]); }
  __syncthreads();
#undef SLOAD
#undef SWRITE
#undef SWAIT
#undef RESC
}
}

__device__ __forceinline__ void p5_attention(Frame& F) {
    const bf16* Q = (const bf16*)(F.ws + WS_Q); const bf16* KV = (const bf16*)(F.ws + WS_KV); const bf16* KPE = (const bf16*)(F.ws + WS_KPE); bf16* O = (bf16*)(F.ws + WS_O);
    const f32x2* ROPE = (const f32x2*)(F.ws + WS_ROPE);
    for (int unit = F.vcu; unit < BATCH * NH * 8; unit += F.G) {
        const int qb = unit & 7, bh = unit >> 3, b = bh >> 3, h = bh & 7; const size_t m0 = (size_t)b * SEQ + qb * 256;
        att::attn_unit(Q + m0 * NQ + h * DQK, KV + (size_t)b * SEQ * NKV + h * 256, KPE + (size_t)b * SEQ * DROPE, O + m0 * AW + h * DV, ROPE + qb * 256 * 32, F.ldsg);
    }
}

__device__ __forceinline__ void p6_mixnorm(Frame& F) {
    const bf16* O = (const bf16*)(F.ws + WS_O); const bf16* YT = (const bf16*)(F.ws + WS_YT); bf16* MIXIN = (bf16*)(F.ws + WS_MIXIN);
    const float* gh = F.in[17]; const float* ga = F.in[18];
    const int gw = F.vcu * NWAVES + F.wave, NGW = F.G * NWAVES, lane = F.lane, tid = F.tid;
    for (int m0 = gw; m0 < M; m0 += NGW * 2) {
        v4u w[2][2];
#pragma unroll
        for (int u = 0; u < 2; ++u)
#pragma unroll
            for (int j = 0; j < 2; ++j) w[u][j] = __builtin_nontemporal_load((const v4u*)(O + (size_t)(m0 + u * NGW) * AW + 8 * (lane + 64 * j)));
#pragma unroll
        for (int u = 0; u < 2; ++u) { const int m = m0 + u * NGW; float s = 0.f;
#pragma unroll
            for (int j = 0; j < 2; ++j) { const unsigned a[4] = {w[u][j].x, w[u][j].y, w[u][j].z, w[u][j].w};
#pragma unroll
                for (int k = 0; k < 4; ++k) { const float x0 = bflo(a[k]), x1 = bfhi(a[k]); s += x0 * x0 + x1 * x1; } }
            const float r = 1.f / sqrtf(wave_sum(s) * (1.f / AW) + EPS);
#pragma unroll
            for (int j = 0; j < 2; ++j) { const int c = 8 * (lane + 64 * j); const unsigned a[4] = {w[u][j].x, w[u][j].y, w[u][j].z, w[u][j].w}; unsigned o[4];
                const f32x4 g0 = *(const f32x4*)(ga + c), g1 = *(const f32x4*)(ga + c + 4); const float g[8] = {g0.x, g0.y, g0.z, g0.w, g1.x, g1.y, g1.z, g1.w};
#pragma unroll
                for (int k = 0; k < 4; ++k) o[k] = pk2(bflo(a[k]) * r * g[2 * k], bfhi(a[k]) * r * g[2 * k + 1]);
                *(v4u*)(MIXIN + (size_t)m * DM + HW + c) = (v4u){o[0], o[1], o[2], o[3]}; } }
    }
    LAS bf16* T = (LAS bf16*)F.lds; constexpr int TP = 1026;
    for (int unit = F.vcu; unit < BATCH * 64; unit += F.G) {
        const int b = unit >> 6, s0 = (unit & 63) * 32;
        __syncthreads();
#pragma unroll
        for (int i = 0; i < 8; ++i) { const int ch = tid & 3, c = (tid >> 2) + 128 * i;
            const v4u w = __builtin_nontemporal_load((const v4u*)(YT + ((size_t)c * BATCH + b) * SEQ + s0 + ch * 8)); const unsigned a[4] = {w.x, w.y, w.z, w.w};
#pragma unroll
            for (int k = 0; k < 4; ++k) { T[(ch * 8 + 2 * k) * TP + c] = (bf16)(a[k] & 0xffffu); T[(ch * 8 + 2 * k + 1) * TP + c] = (bf16)(a[k] >> 16); } }
        __syncthreads();
#pragma unroll
        for (int q = 0; q < 4; ++q) { const int sl = F.wave * 4 + q; unsigned v[8]; float s = 0.f;
#pragma unroll
            for (int k = 0; k < 8; ++k) { v[k] = *(const LAS unsigned*)(T + sl * TP + 2 * lane + 128 * k); const float x0 = bflo(v[k]), x1 = bfhi(v[k]); s += x0 * x0 + x1 * x1; }
            const float r = 1.f / sqrtf(wave_sum(s) * (1.f / HW) + EPS);
            bf16* orow = MIXIN + ((size_t)b * SEQ + s0 + sl) * DM;
#pragma unroll
            for (int k = 0; k < 8; ++k) { const int c = 2 * lane + 128 * k; const f32x2 g = *(const f32x2*)(gh + c);
                *(unsigned*)(orow + c) = pk2(bflo(v[k]) * r * g.x, bfhi(v[k]) * r * g.y); } }
    }
    __syncthreads();
}

__device__ __forceinline__ void p8_postmix(Frame& F) {
    const bf16* MIXED = (const bf16*)(F.ws + WS_MIXED); bf16* XN = (bf16*)(F.ws + WS_XN);
    const float* x = F.in[0]; const float* gpost = F.in[20]; const float* gpre = F.in[21]; bf16* H16 = (bf16*)(F.ws + WS_H16);
    const int gw = F.vcu * NWAVES + F.wave, NGW = F.G * NWAVES, lane = F.lane;
    for (int m = gw; m < M; m += NGW) {
        float mx[32]; float s = 0.f;
#pragma unroll
        for (int j = 0; j < 4; ++j) { const v4u w = *(const v4u*)(MIXED + (size_t)m * DM + 8 * (lane + 64 * j)); const unsigned a[4] = {w.x, w.y, w.z, w.w};
#pragma unroll
            for (int k = 0; k < 4; ++k) { mx[8 * j + 2 * k] = bflo(a[k]); mx[8 * j + 2 * k + 1] = bfhi(a[k]); s += mx[8 * j + 2 * k] * mx[8 * j + 2 * k] + mx[8 * j + 2 * k + 1] * mx[8 * j + 2 * k + 1]; } }
        const float r = 1.f / sqrtf(wave_sum(s) * (1.f / DM) + EPS);
        float s2 = 0.f;
#pragma unroll
        for (int j = 0; j < 4; ++j) { const int c = 8 * (lane + 64 * j);
#pragma unroll
            for (int hh = 0; hh < 2; ++hh) { const f32x4 xv = *(const f32x4*)(x + (size_t)m * DM + c + 4 * hh); const f32x4 g = *(const f32x4*)(gpost + c + 4 * hh);
                f32x4 hv; hv.x = xv.x + mx[8 * j + 4 * hh] * r * g.x; hv.y = xv.y + mx[8 * j + 4 * hh + 1] * r * g.y; hv.z = xv.z + mx[8 * j + 4 * hh + 2] * r * g.z; hv.w = xv.w + mx[8 * j + 4 * hh + 3] * r * g.w;
                mx[8 * j + 4 * hh] = hv.x; mx[8 * j + 4 * hh + 1] = hv.y; mx[8 * j + 4 * hh + 2] = hv.z; mx[8 * j + 4 * hh + 3] = hv.w;
                s2 += (hv.x * hv.x + hv.y * hv.y) + (hv.z * hv.z + hv.w * hv.w); } }
        const float s2t = wave_sum(s2); if (lane == 0) ((float*)(F.ws + WS_SS2))[m] = s2t;
        const float r2 = 1.f / sqrtf(s2t * (1.f / DM) + EPS);
#pragma unroll
        for (int j = 0; j < 4; ++j) { const int c = 8 * (lane + 64 * j); const f32x4 g0 = *(const f32x4*)(gpre + c), g1 = *(const f32x4*)(gpre + c + 4);
            { v4u hq; hq.x = pk2(mx[8 * j], mx[8 * j + 1]); hq.y = pk2(mx[8 * j + 2], mx[8 * j + 3]); hq.z = pk2(mx[8 * j + 4], mx[8 * j + 5]); hq.w = pk2(mx[8 * j + 6], mx[8 * j + 7]);
              *(v4u*)(H16 + (size_t)m * DM + c) = hq; }
            v4u o; o.x = pk2(mx[8 * j] * r2 * g0.x, mx[8 * j + 1] * r2 * g0.y); o.y = pk2(mx[8 * j + 2] * r2 * g0.z, mx[8 * j + 3] * r2 * g0.w);
            o.z = pk2(mx[8 * j + 4] * r2 * g1.x, mx[8 * j + 5] * r2 * g1.y); o.w = pk2(mx[8 * j + 6] * r2 * g1.z, mx[8 * j + 7] * r2 * g1.w);
            *(v4u*)(XN + (size_t)m * DM + c) = o; }
    }
}
__device__ __forceinline__ void p10_fixup(Frame& F) {
    const f32x4* BB = (const f32x4*)(F.ws + WS_BB); bf16* ACT = (bf16*)(F.ws + WS_ACT);
    const float* cw = F.in[23];
    constexpr int UB = 8, NE = 512 * DFF;
    const int stride = F.G * NTHR;
    for (int i0 = F.vcu * NTHR + F.tid; i0 < NE; i0 += stride * UB) {
        f32x4 v[UB]; float gn[UB], wn[UB]; int rr[UB], cc[UB]; bool ok[UB];
#pragma unroll
        for (int u = 0; u < UB; ++u) { int i = i0 + u * stride; ok[u] = (i < NE); i = ok[u] ? i : i0;
            const int q = i / DFF, c = i - q * DFF, chunk = q >> 1, last = q & 1; const int r = chunk * 64 + (last ? 63 : 0);
            const bool un = last ? (((r + 1) & (SEQ - 1)) != 0) : ((r & (SEQ - 1)) != 0);
            const int ni = un ? (last ? i + DFF : i - DFF) : i;
            v[u] = BB[i]; gn[u] = un ? BB[ni].y : 0.f; wn[u] = cw[(last ? 2 * DFF : 0) + c]; rr[u] = r; cc[u] = c; }
#pragma unroll
        for (int u = 0; u < UB; ++u) { const float pre = v[u].x + wn[u] * gn[u];
            if (ok[u]) ACT[(size_t)rr[u] * DFF + cc[u]] = (bf16)f2bf(pg8::gelu_tanh(pre) * v[u].z); }
    }
}
__device__ __forceinline__ void p12_final(Frame& F) {
    const bf16* FB = (const bf16*)(F.ws + WS_F); const bf16* H16 = (const bf16*)(F.ws + WS_H16); const float* g = F.in[26]; float* out = F.out;
    const int gw = F.vcu * NWAVES + F.wave, NGW = F.G * NWAVES, lane = F.lane;
    for (int m = gw; m < M; m += NGW) {
        float fx[32]; float s = 0.f; v4u hw[4];
#pragma unroll
        for (int j = 0; j < 4; ++j) { const v4u w = *(const v4u*)(FB + (size_t)m * DM + 8 * (lane + 64 * j)); hw[j] = *(const v4u*)(H16 + (size_t)m * DM + 8 * (lane + 64 * j)); const unsigned a[4] = {w.x, w.y, w.z, w.w};
#pragma unroll
            for (int k = 0; k < 4; ++k) { fx[8 * j + 2 * k] = bflo(a[k]); fx[8 * j + 2 * k + 1] = bfhi(a[k]); s += fx[8 * j + 2 * k] * fx[8 * j + 2 * k] + fx[8 * j + 2 * k + 1] * fx[8 * j + 2 * k + 1]; } }
        const float r = 1.f / sqrtf(wave_sum(s) * (1.f / DM) + EPS);
#pragma unroll
        for (int j = 0; j < 4; ++j) { const int c = 8 * (lane + 64 * j); const unsigned hh4[4] = {hw[j].x, hw[j].y, hw[j].z, hw[j].w};
#pragma unroll
            for (int hh = 0; hh < 2; ++hh) { float* p = out + (size_t)m * DM + c + 4 * hh; const f32x4 gg = *(const f32x4*)(g + c + 4 * hh);
                f32x4 ov; ov.x = bflo(hh4[2 * hh]) + fx[8 * j + 4 * hh] * r * gg.x; ov.y = bfhi(hh4[2 * hh]) + fx[8 * j + 4 * hh + 1] * r * gg.y;
                ov.z = bflo(hh4[2 * hh + 1]) + fx[8 * j + 4 * hh + 2] * r * gg.z; ov.w = bfhi(hh4[2 * hh + 1]) + fx[8 * j + 4 * hh + 3] * r * gg.w;
                *(f32x4*)p = ov; } }
    }
}

struct Args { const float* in[27]; float* out; unsigned char* ws; int ph_lo, ph_hi; };
template <bool COOP>
__global__ void __launch_bounds__(NTHR, 2) mk_fwd(Args args) {
    extern __shared__ __attribute__((aligned(16))) unsigned char lds[];
    Frame F;
    F.lds = (LAS unsigned char*)lds; F.ldsg = (char*)lds;
    F.tid = threadIdx.x; F.lane = F.tid & 63; F.wave = __builtin_amdgcn_readfirstlane(F.tid >> 6);
    F.G = gridDim.x; { const int bx = blockIdx.x; F.vcu = (F.G % 8 == 0) ? (bx % 8) * (F.G / 8) + bx / 8 : bx; }
#pragma unroll
    for (int i = 0; i < 27; ++i) F.in[i] = args.in[i];
    F.out = args.out; F.ws = args.ws;
    unsigned char* ws = args.ws;
    const int lo = args.ph_lo, hi = args.ph_hi;
    volatile LAS unsigned* MISC = (volatile LAS unsigned*)(F.lds + 131072 + 320);
    XcdBarrier bar; bar.bar = (unsigned*)ws; bar.x = 0; bar.st = nullptr;
    if (COOP) { if (F.tid < 32) MISC[F.tid] = 0u; __syncthreads(); bar = xcd_barrier_post((unsigned*)ws, MISC + 8);
        p0_pre(F);
        if (F.G != 256) cg::this_grid().sync(); }
#ifndef PROBE_REP
#define PROBE_REP 0
#endif
#define REP(k) for (int rep_ = 0; rep_ < 1 + ((PROBE_REP >> (k)) & 1); ++rep_)
#define IN(k) (lo <= (k) && (k) < hi)
#define SEAM(k) do { if (COOP && IN((k) + 1)) xcd_barrier(bar); } while (0)
#ifndef SKIP_P0
    if (IN(0)) { REP(0) p0_prologue(F); SEAM(0); }
#endif
    if (IN(1)) { pg8::Gemm g{(const bf16*)(ws + WS_XN), (const bf16*)(ws + WS_WIN), M, INWP, DM}; pg8::StaticOrder S; S.init(M, INWP, F.G, (int)blockIdx.x);
        pg8::EpiStore E{(bf16*)(ws + WS_PROJ), INWP};
        pg8::gemm_phase<pg8::EpiStore, pg8::StaticOrder, true, true>(F.lds, g, S, E); SEAM(1); }
    if (IN(2)) { REP(2) { p2_hyena_prep(F); p2_mla_prep(F); p2_filter_out(F); } SEAM(2); }
    if (IN(3)) {
#ifndef SKIP_LC
        REP(3) p4_longconv(F);
#endif
        { pg8::Gemm g{(const bf16*)(ws + WS_CQN), (const bf16*)(ws + WS_WUQ), M, NQ, QLR}; pg8::StaticOrder S; S.init(M, NQ, F.G, (int)blockIdx.x);
          pg8::EpiStore E{(bf16*)(ws + WS_Q), NQ};
          pg8::gemm_phase<pg8::EpiStore, pg8::StaticOrder, true, true>(F.lds, g, S, E); }
        { pg8::Gemm g{(const bf16*)(ws + WS_CKVN), (const bf16*)(ws + WS_WUKV), M, NKV, KVLR}; pg8::StaticOrder S; S.init(M, NKV, F.G, (int)blockIdx.x);
          pg8::EpiStore E{(bf16*)(ws + WS_KV), NKV};
          pg8::gemm_phase<pg8::EpiStore, pg8::StaticOrder, true, true>(F.lds, g, S, E); }
        SEAM(3); }
    #ifndef SKIP_ATT
    if (IN(4)) { REP(4) p5_attention(F); SEAM(4); }
#endif
    if (IN(5)) { REP(5) p6_mixnorm(F); SEAM(5); }
    const bool fused = (F.G == 256);
    if (IN(6)) { pg8::Gemm g{(const bf16*)(ws + WS_MIXIN), (const bf16*)(ws + WS_WOUT), M, DM, DM}; pg8::StaticOrder S; S.init(M, DM, F.G, (int)blockIdx.x);
        if (fused) { pg8::EpiMixRes E{(bf16*)(ws + WS_MIXED), F.in[0], F.in[20], (bf16*)(ws + WS_H16), (float*)(ws + WS_SS1), (float*)(ws + WS_SS2), (unsigned*)(ws + WS_CNT), DM, EPS};
            pg8::gemm_phase<pg8::EpiMixRes, pg8::StaticOrder, true, true>(F.lds, g, S, E); }
        else { pg8::EpiStore E{(bf16*)(ws + WS_MIXED), DM};
            pg8::gemm_phase<pg8::EpiStore, pg8::StaticOrder, true, true>(F.lds, g, S, E); if (COOP) xcd_barrier(bar); p8_postmix(F); }
        SEAM(7); }
#ifndef SKIP_GEGLU
    if (IN(8)) { pg8::Gemm g{(const bf16*)(ws + WS_H16), (const bf16*)(ws + WS_WUP), M, 2 * DFF, DM}; pg8::StaticOrder S; S.init(M, 2 * DFF, F.G, (int)blockIdx.x);
        pg8::EpiGeglu E{(bf16*)(ws + WS_ACT), F.in[23], F.in[24], (pg8::f32x4*)(ws + WS_BB), DFF, (const float*)(ws + WS_SS2), EPS};
        pg8::gemm_phase<pg8::EpiGeglu, pg8::StaticOrder, true, true>(F.lds, g, S, E); SEAM(8); }
#endif
    if (IN(9)) { REP(9) p10_fixup(F); SEAM(9); }
    if (IN(10)) { pg8::Gemm g{(const bf16*)(ws + WS_ACT), (const bf16*)(ws + WS_WDOWN), M, DM, DFF}; pg8::StaticOrder S; S.init(M, DM, F.G, (int)blockIdx.x);
        if (fused) { pg8::EpiFinal E{(bf16*)(ws + WS_F), (const bf16*)(ws + WS_H16), F.in[26], F.out, (float*)(ws + WS_SS3), (unsigned*)(ws + WS_CNT2), DM, EPS};
            pg8::gemm_phase<pg8::EpiFinal, pg8::StaticOrder, true, true>(F.lds, g, S, E); }
        else { pg8::EpiStore E{(bf16*)(ws + WS_F), DM};
            pg8::gemm_phase<pg8::EpiStore, pg8::StaticOrder, true, true>(F.lds, g, S, E); if (COOP) xcd_barrier(bar); p12_final(F); } }
#undef IN
#undef SEAM
}

extern "C" void kernel_launch(void* const* d_in, const int* in_sizes, int n_in, void* d_out, int out_size, void* d_ws, size_t ws_size, hipStream_t stream) {
    static int grid = 0;
    if (grid == 0) {
        if (n_in != 27 || in_sizes[0] != M * DM || out_size != M * DM || ws_size < WS_END) { fprintf(stderr, "kernel_launch: unexpected shapes: n_in %d in0 %d out %d ws %zu (need %zu)\n", n_in, n_in > 0 ? in_sizes[0] : -1, out_size, ws_size, (size_t)WS_END); grid = -1; return; }
        int dev = 0, cus = 0;
        if (hipGetDevice(&dev) != hipSuccess || hipDeviceGetAttribute(&cus, hipDeviceAttributeMultiprocessorCount, dev) != hipSuccess) { grid = -1; return; }
        if (hipFuncSetAttribute((const void*)mk_fwd<true>, hipFuncAttributeMaxDynamicSharedMemorySize, LDS_BYTES) != hipSuccess ||
            hipFuncSetAttribute((const void*)mk_fwd<false>, hipFuncAttributeMaxDynamicSharedMemorySize, LDS_BYTES) != hipSuccess) { fprintf(stderr, "kernel_launch: hipFuncSetAttribute failed\n"); grid = -1; return; }
        int per_cu = 0;
        if (hipOccupancyMaxActiveBlocksPerMultiprocessor(&per_cu, (const void*)mk_fwd<true>, NTHR, LDS_BYTES) != hipSuccess || per_cu < 1) { fprintf(stderr, "kernel_launch: occupancy query says %d\n", per_cu); }
        (void)hipGetLastError();
        grid = cus;
    }
    if (grid < 0) return;
    Args a{};
    for (int i = 0; i < 27; ++i) a.in[i] = (const float*)d_in[i];
    a.out = (float*)d_out; a.ws = (unsigned char*)d_ws;
    if (MK_N_LAUNCHES == 1) {
        a.ph_lo = 0; a.ph_hi = 12;
        if (hipMemsetAsync(d_ws, 0, CTL_BYTES, stream) != hipSuccess) { fprintf(stderr, "kernel_launch: memset failed\n"); return; }
        void* kargs[] = {&a};
        hipError_t e = hipLaunchCooperativeKernel((const void*)mk_fwd<true>, dim3(grid), dim3(NTHR), kargs, LDS_BYTES, stream);
        if (e != hipSuccess) fprintf(stderr, "kernel_launch: cooperative launch failed: %s (grid %d)\n", hipGetErrorString(e), grid);
    } else {
        for (int p = 0; p < 12; ++p) { a.ph_lo = p; a.ph_hi = p + 1;
            hipLaunchKernelGGL(mk_fwd<false>, dim3(grid), dim3(NTHR), LDS_BYTES, stream, a);
            const hipError_t le = hipPeekAtLastError();
            if (le != hipSuccess) { fprintf(stderr, "kernel_launch: launch %d failed: %s\n", p, hipGetErrorName(le)); break; } }
    }
}
```

```cpp
#include <hip/hip_runtime.h>
#include <hip/hip_cooperative_groups.h>
#include <cstdio>
#include <cstdint>
namespace cg = cooperative_groups;
#ifndef MK_N_LAUNCHES
#define MK_N_LAUNCHES 1
#endif
namespace pg8 {
#define PG8_LAS __attribute__((address_space(3)))
typedef unsigned short bf16_t;
typedef short bf16x8 __attribute__((ext_vector_type(8)));
typedef float f32x4 __attribute__((ext_vector_type(4)));
typedef unsigned u32x4 __attribute__((ext_vector_type(4)));
constexpr int BM = 256, BK = 64, HALF = 128, HTB = HALF * BK * 2  , STAGE_BYTES = 8 * HTB, NXCD = 8, WGM = 8;

__host__ __device__ __forceinline__ int lds_byte(int r, int c) { const int st = (r >> 4) * 2 + (c >> 5), rr = r & 15, cc = c & 31, ob = rr * 64 + cc * 2; return st * 1024 + (ob ^ (((ob >> 9) & 1) << 5)); }
__host__ __device__ __forceinline__ void stage_rc(int b, int& R, int& C) { const int st = b / 1024, sb = b % 1024, swz = sb ^ (((sb >> 9) & 1) << 5); R = (st >> 1) * 16 + swz / 64; C = (st & 1) * 32 + (swz % 64) / 2; }
__host__ __device__ __forceinline__ int perm32(int rho) { const int n = rho >> 4, i = rho & 15; return 8 * (i >> 2) + 4 * n + (i & 3); }

struct Unit { int pm, pn; };
struct Gemm { const bf16_t* A; const bf16_t* Bt; int M, N, K; };

struct StaticOrder {
    int nM, nN, nwg, G, c;
    __host__ __device__ void init(int M, int N, int G_, int c_) { nM = M / BM; nN = N / BM; nwg = nM * nN; G = G_; c = c_; }
    __host__ __device__ bool next(int i, Unit& u) const {
        const long L = (long)i * G + c; if (L >= nwg) return false;
        int wgid = (int)L; { const int q = nwg / NXCD, r = nwg % NXCD, xcd = wgid % NXCD, off = wgid / NXCD; wgid = (xcd < r ? xcd * (q + 1) : r * (q + 1) + (xcd - r) * q) + off; }
        const int nig = WGM * nN, gid = wgid / nig, fm = gid * WGM, gsz = (nM - fm) < WGM ? (nM - fm) : WGM;
        u.pm = fm + ((wgid % nig) % gsz); u.pn = (wgid % nig) / gsz; return true;
    }
    __device__ __forceinline__ void a_ready(const Unit&) const {}
    __device__ __forceinline__ void done(const Unit&) const {}
};

__device__ __forceinline__ unsigned cvt_pk_bf16(float lo, float hi) { unsigned r; asm volatile("v_cvt_pk_bf16_f32 %0, %1, %2" : "=v"(r) : "v"(lo), "v"(hi)); return r; }
typedef float f32x2 __attribute__((ext_vector_type(2)));

struct EpiStore {
    static constexpr bool PERM = true, AFTER_DRAIN = false;
    bf16_t* O; int ldc;
    __device__ __forceinline__ void operator()(const f32x4 (&acc)[2][2][4][2], const Unit& u, int wr, int wc, int fr, int fq) const {
        const int row0 = u.pm * BM + wr * 64 + fr; const int col0 = u.pn * BM + wc * 32 + 8 * fq;
#pragma unroll
        for (int ai = 0; ai < 2; ++ai)
#pragma unroll
            for (int m = 0; m < 4; ++m) { bf16_t* rowp = O + (size_t)(row0 + ai * HALF + m * 16) * ldc + col0;
#pragma unroll
                for (int bj = 0; bj < 2; ++bj) { const f32x4 v0 = acc[ai][bj][m][0], v1 = acc[ai][bj][m][1];
                    u32x4 w; w.x = cvt_pk_bf16(v0[0], v0[1]); w.y = cvt_pk_bf16(v0[2], v0[3]); w.z = cvt_pk_bf16(v1[0], v1[1]); w.w = cvt_pk_bf16(v1[2], v1[3]);
                    *(u32x4*)(rowp + bj * HALF) = w; } }
    }
};

struct EpiMixRes {
    static constexpr bool PERM = true, AFTER_DRAIN = false;
    bf16_t* MIXED; const float* x; const float* gpost; bf16_t* H16; float* SS1; float* SS2; unsigned* CNT; int ldc; float eps;
    __device__ __forceinline__ void fin8(const f32x4& v0, const f32x4& v1, float r1, size_t o, int col, float& s2) const {
        const f32x4 x0 = __builtin_nontemporal_load((const f32x4*)(x + o)), x1 = __builtin_nontemporal_load((const f32x4*)(x + o + 4)), g0 = *(const f32x4*)(gpost + col), g1 = *(const f32x4*)(gpost + col + 4);
        const f32x4 h0 = x0 + (v0 * r1) * g0, h1 = x1 + (v1 * r1) * g1;
        s2 += (h0[0] * h0[0] + h0[1] * h0[1]) + (h0[2] * h0[2] + h0[3] * h0[3]) + (h1[0] * h1[0] + h1[1] * h1[1]) + (h1[2] * h1[2] + h1[3] * h1[3]);
        u32x4 w; w.x = cvt_pk_bf16(h0[0], h0[1]); w.y = cvt_pk_bf16(h0[2], h0[3]); w.z = cvt_pk_bf16(h1[0], h1[1]); w.w = cvt_pk_bf16(h1[2], h1[3]);
        *(u32x4*)(H16 + o) = w;
    }
    __device__ __forceinline__ void operator()(const f32x4 (&acc)[2][2][4][2], const Unit& u, int wr, int wc, int fr, int fq) const {
        const bool second = (u.pn >= 4);
        const int row0 = u.pm * BM + wr * 64 + fr; const int col0 = u.pn * BM + wc * 32 + 8 * fq;
#pragma unroll
        for (int ai = 0; ai < 2; ++ai)
#pragma unroll
            for (int m = 0; m < 4; ++m) { float s = 0.f;
#pragma unroll
                for (int bj = 0; bj < 2; ++bj)
#pragma unroll
                    for (int n = 0; n < 2; ++n) { const f32x4 v = acc[ai][bj][m][n]; s += (v[0] * v[0] + v[1] * v[1]) + (v[2] * v[2] + v[3] * v[3]); }
                s += __shfl_xor(s, 16); s += __shfl_xor(s, 32);
                if (fq == 0) (void)__hip_atomic_fetch_add(SS1 + row0 + ai * HALF + m * 16, s, __ATOMIC_RELAXED, __HIP_MEMORY_SCOPE_AGENT); }
        if (!second) {
#pragma unroll
            for (int ai = 0; ai < 2; ++ai)
#pragma unroll
                for (int m = 0; m < 4; ++m) { bf16_t* rowp = MIXED + (size_t)(row0 + ai * HALF + m * 16) * ldc + col0;
#pragma unroll
                    for (int bj = 0; bj < 2; ++bj) { const f32x4 v0 = acc[ai][bj][m][0], v1 = acc[ai][bj][m][1];
                        u32x4 w; w.x = cvt_pk_bf16(v0[0], v0[1]); w.y = cvt_pk_bf16(v0[2], v0[3]); w.z = cvt_pk_bf16(v1[0], v1[1]); w.w = cvt_pk_bf16(v1[2], v1[3]);
                        *(u32x4*)(rowp + bj * HALF) = w; } }
            return;
        }
        asm volatile("s_waitcnt vmcnt(0)" ::: "memory");
        __builtin_amdgcn_s_barrier();
        if (threadIdx.x == 0) {
            __builtin_amdgcn_fence(__ATOMIC_RELEASE, "agent");
            (void)__hip_atomic_fetch_add(CNT + 64 * u.pm, 1u, __ATOMIC_RELAXED, __HIP_MEMORY_SCOPE_AGENT);
            unsigned sp = 0;
            while (__hip_atomic_load(CNT + 64 * u.pm, __ATOMIC_RELAXED, __HIP_MEMORY_SCOPE_AGENT) < 4u) { __builtin_amdgcn_s_sleep(2); if (++sp > (1u << 22)) break; }
            __builtin_amdgcn_fence(__ATOMIC_ACQUIRE, "agent");
        }
        __builtin_amdgcn_s_barrier();
        asm volatile("" ::: "memory");
#pragma unroll
        for (int ai = 0; ai < 2; ++ai)
#pragma unroll
            for (int m = 0; m < 4; ++m) { const int row = row0 + ai * HALF + m * 16;
                const float r1 = 1.f / sqrtf(__hip_atomic_load(SS1 + row, __ATOMIC_RELAXED, __HIP_MEMORY_SCOPE_AGENT) * (1.f / 2048.f) + eps);
                float s2 = 0.f;
#pragma unroll
                for (int bj = 0; bj < 2; ++bj) {
                    const int col = col0 + bj * HALF; const size_t o = (size_t)row * ldc + col;
                    fin8(acc[ai][bj][m][0], acc[ai][bj][m][1], r1, o, col, s2);
                    const int colp = col - 4 * BM; const size_t op = (size_t)row * ldc + colp;
                    const u32x4 w = *(const u32x4*)(MIXED + op);
                    const f32x4 p0 = {__builtin_bit_cast(float, w.x << 16), __builtin_bit_cast(float, w.x & 0xffff0000u), __builtin_bit_cast(float, w.y << 16), __builtin_bit_cast(float, w.y & 0xffff0000u)};
                    const f32x4 p1 = {__builtin_bit_cast(float, w.z << 16), __builtin_bit_cast(float, w.z & 0xffff0000u), __builtin_bit_cast(float, w.w << 16), __builtin_bit_cast(float, w.w & 0xffff0000u)};
                    fin8(p0, p1, r1, op, colp, s2); }
                s2 += __shfl_xor(s2, 16); s2 += __shfl_xor(s2, 32);
                if (fq == 0) (void)__hip_atomic_fetch_add(SS2 + row, s2, __ATOMIC_RELAXED, __HIP_MEMORY_SCOPE_AGENT); }
    }
};

struct EpiFinal {
    static constexpr bool PERM = true, AFTER_DRAIN = false;
    bf16_t* FB; const bf16_t* H16; const float* gain; float* out; float* SS; unsigned* CNT; int ldc; float eps;
    __device__ __forceinline__ void fin8(const f32x4& v0, const f32x4& v1, float r, size_t o, int col) const {
        const u32x4 hw = __builtin_nontemporal_load((const u32x4*)(H16 + o)); const f32x4 g0 = *(const f32x4*)(gain + col), g1 = *(const f32x4*)(gain + col + 4);
        const f32x4 h0 = {__builtin_bit_cast(float, hw.x << 16), __builtin_bit_cast(float, hw.x & 0xffff0000u), __builtin_bit_cast(float, hw.y << 16), __builtin_bit_cast(float, hw.y & 0xffff0000u)};
        const f32x4 h1 = {__builtin_bit_cast(float, hw.z << 16), __builtin_bit_cast(float, hw.z & 0xffff0000u), __builtin_bit_cast(float, hw.w << 16), __builtin_bit_cast(float, hw.w & 0xffff0000u)};
        __builtin_nontemporal_store(h0 + (v0 * r) * g0, (f32x4*)(out + o)); __builtin_nontemporal_store(h1 + (v1 * r) * g1, (f32x4*)(out + o + 4));
    }
    __device__ __forceinline__ void operator()(const f32x4 (&acc)[2][2][4][2], const Unit& u, int wr, int wc, int fr, int fq) const {
        const bool second = (u.pn >= 4);
        const int row0 = u.pm * BM + wr * 64 + fr; const int col0 = u.pn * BM + wc * 32 + 8 * fq;
#pragma unroll
        for (int ai = 0; ai < 2; ++ai)
#pragma unroll
            for (int m = 0; m < 4; ++m) { float s = 0.f;
#pragma unroll
                for (int bj = 0; bj < 2; ++bj)
#pragma unroll
                    for (int n = 0; n < 2; ++n) { const f32x4 v = acc[ai][bj][m][n]; s += (v[0] * v[0] + v[1] * v[1]) + (v[2] * v[2] + v[3] * v[3]); }
                s += __shfl_xor(s, 16); s += __shfl_xor(s, 32);
                if (fq == 0) (void)__hip_atomic_fetch_add(SS + row0 + ai * HALF + m * 16, s, __ATOMIC_RELAXED, __HIP_MEMORY_SCOPE_AGENT); }
        if (!second) {
#pragma unroll
            for (int ai = 0; ai < 2; ++ai)
#pragma unroll
                for (int m = 0; m < 4; ++m) { bf16_t* rowp = FB + (size_t)(row0 + ai * HALF + m * 16) * ldc + col0;
#pragma unroll
                    for (int bj = 0; bj < 2; ++bj) { const f32x4 v0 = acc[ai][bj][m][0], v1 = acc[ai][bj][m][1];
                        u32x4 w; w.x = cvt_pk_bf16(v0[0], v0[1]); w.y = cvt_pk_bf16(v0[2], v0[3]); w.z = cvt_pk_bf16(v1[0], v1[1]); w.w = cvt_pk_bf16(v1[2], v1[3]);
                        *(u32x4*)(rowp + bj * HALF) = w; } }
            return;
        }
        asm volatile("s_waitcnt vmcnt(0)" ::: "memory");
        __builtin_amdgcn_s_barrier();
        if (threadIdx.x == 0) {
            __builtin_amdgcn_fence(__ATOMIC_RELEASE, "agent");
            (void)__hip_atomic_fetch_add(CNT + 64 * u.pm, 1u, __ATOMIC_RELAXED, __HIP_MEMORY_SCOPE_AGENT);
            unsigned sp = 0;
            while (__hip_atomic_load(CNT + 64 * u.pm, __ATOMIC_RELAXED, __HIP_MEMORY_SCOPE_AGENT) < 4u) { __builtin_amdgcn_s_sleep(2); if (++sp > (1u << 22)) break; }
            __builtin_amdgcn_fence(__ATOMIC_ACQUIRE, "agent");
        }
        __builtin_amdgcn_s_barrier();
        asm volatile("" ::: "memory");
#pragma unroll
        for (int ai = 0; ai < 2; ++ai)
#pragma unroll
            for (int m = 0; m < 4; ++m) { const int row = row0 + ai * HALF + m * 16;
                const float r = 1.f / sqrtf(__hip_atomic_load(SS + row, __ATOMIC_RELAXED, __HIP_MEMORY_SCOPE_AGENT) * (1.f / 2048.f) + eps);
#pragma unroll
                for (int bj = 0; bj < 2; ++bj) {
                    const int col = col0 + bj * HALF; const size_t o = (size_t)row * ldc + col;
                    fin8(acc[ai][bj][m][0], acc[ai][bj][m][1], r, o, col);
                    const int colp = col - 4 * BM; const size_t op = (size_t)row * ldc + colp;
                    const u32x4 w = __builtin_nontemporal_load((const u32x4*)(FB + op));
                    const f32x4 p0 = {__builtin_bit_cast(float, w.x << 16), __builtin_bit_cast(float, w.x & 0xffff0000u), __builtin_bit_cast(float, w.y << 16), __builtin_bit_cast(float, w.y & 0xffff0000u)};
                    const f32x4 p1 = {__builtin_bit_cast(float, w.z << 16), __builtin_bit_cast(float, w.z & 0xffff0000u), __builtin_bit_cast(float, w.w << 16), __builtin_bit_cast(float, w.w & 0xffff0000u)};
                    fin8(p0, p1, r, op, colp); } }
    }
};

__device__ __forceinline__ float gelu_tanh(float x) {
    const float z = 0.7978845608028654f * (x + 0.044715f * x * x * x);
    const float e = __builtin_amdgcn_exp2f(-2.885390081777927f * z);
    return x * __builtin_amdgcn_rcpf(1.f + e);
}
#ifndef MK_DPP
#define MK_DPP 1
#endif
#if MK_DPP
__device__ __forceinline__ float ror1(float v) { return __builtin_bit_cast(float, __builtin_amdgcn_update_dpp(0, __builtin_bit_cast(int, v), 0x121, 0xf, 0xf, true)); }
__device__ __forceinline__ float rol1(float v) { return __builtin_bit_cast(float, __builtin_amdgcn_update_dpp(0, __builtin_bit_cast(int, v), 0x12f, 0xf, 0xf, true)); }
#else
__device__ __forceinline__ float ror1(float v) { const int l = threadIdx.x & 63; return __shfl(v, (l & 48) | ((l - 1) & 15)); }
__device__ __forceinline__ float rol1(float v) { const int l = threadIdx.x & 63; return __shfl(v, (l & 48) | ((l + 1) & 15)); }
#endif

struct EpiGeglu {
    static constexpr bool PERM = true, AFTER_DRAIN = false;
    bf16_t* ACT; const float* cw; const float* cb; f32x4* BB; int dff; const float* SS2; float eps;
    __device__ __forceinline__ void operator()(const f32x4 (&acc)[2][2][4][2], const Unit& u, int wr, int wc, int fr, int fq) const {
        const int gc0 = u.pn * 128 + wc * 32 + 8 * fq;
        f32x2 w0[4], w1[4], w2[4], bb[4];
        { const f32x4 a0 = *(const f32x4*)(cw + gc0), a1 = *(const f32x4*)(cw + gc0 + 4), b0 = *(const f32x4*)(cw + dff + gc0), b1 = *(const f32x4*)(cw + dff + gc0 + 4);
          const f32x4 c0 = *(const f32x4*)(cw + 2 * dff + gc0), c1 = *(const f32x4*)(cw + 2 * dff + gc0 + 4), d0 = *(const f32x4*)(cb + gc0), d1 = *(const f32x4*)(cb + gc0 + 4);
          w0[0] = (f32x2){a0.x, a0.y}; w0[1] = (f32x2){a0.z, a0.w}; w0[2] = (f32x2){a1.x, a1.y}; w0[3] = (f32x2){a1.z, a1.w};
          w1[0] = (f32x2){b0.x, b0.y}; w1[1] = (f32x2){b0.z, b0.w}; w1[2] = (f32x2){b1.x, b1.y}; w1[3] = (f32x2){b1.z, b1.w};
          w2[0] = (f32x2){c0.x, c0.y}; w2[1] = (f32x2){c0.z, c0.w}; w2[2] = (f32x2){c1.x, c1.y}; w2[3] = (f32x2){c1.z, c1.w};
          bb[0] = (f32x2){d0.x, d0.y}; bb[1] = (f32x2){d0.z, d0.w}; bb[2] = (f32x2){d1.x, d1.y}; bb[3] = (f32x2){d1.z, d1.w}; }
        const f32x2 K1 = (f32x2){-2.302208198f, -2.302208198f}, K2 = (f32x2){-0.102943239f, -0.102943239f}, ONE = (f32x2){1.f, 1.f}, ZERO = (f32x2){0.f, 0.f};
        const bool f0 = (fr == 0), f15 = (fr == 15);
#pragma unroll
        for (int ai = 0; ai < 2; ++ai) {
            const int chunk = u.pm * 4 + ai * 2 + wr; const int rbase = chunk * 64;
            f32x4* pF = BB + (size_t)(chunk * 2) * dff + gc0; f32x4* pL = pF + dff;
            unsigned pk[4][4];
            f32x2 rs[4];
#pragma unroll
            for (int m = 0; m < 4; ++m) { const float t = 1.f / sqrtf(SS2[rbase + m * 16 + fr] * (1.f / 2048.f) + eps); rs[m] = (f32x2){t, t}; }
#pragma unroll
            for (int jp = 0; jp < 4; ++jp) { const int n = jp >> 1, e0 = (jp & 1) * 2;
                f32x2 G[4], R[4], L[4];
#pragma unroll
                for (int m = 0; m < 4; ++m) { G[m] = (f32x2){acc[ai][0][m][n][e0], acc[ai][0][m][n][e0 + 1]} * rs[m];
                    R[m] = (f32x2){ror1(G[m].x), ror1(G[m].y)}; L[m] = (f32x2){rol1(G[m].x), rol1(G[m].y)}; }
#pragma unroll
                for (int m = 0; m < 4; ++m) {
                    const f32x2 uu = (f32x2){acc[ai][1][m][n][e0], acc[ai][1][m][n][e0 + 1]} * rs[m];
                    const f32x2 gup = f0 ? (m > 0 ? R[m > 0 ? m - 1 : 0] : ZERO) : R[m];
                    const f32x2 gdn = f15 ? (m < 3 ? L[m < 3 ? m + 1 : 3] : ZERO) : L[m];
                    const f32x2 pre = w0[jp] * gup + (w1[jp] * G[m] + (w2[jp] * gdn + bb[jp]));
                    const f32x2 a = pre * ((pre * pre) * K2 + K1);
                    f32x2 e; e.x = __builtin_amdgcn_exp2f(a.x); e.y = __builtin_amdgcn_exp2f(a.y);
                    const f32x2 d = e + ONE;
                    f32x2 r; r.x = __builtin_amdgcn_rcpf(d.x); r.y = __builtin_amdgcn_rcpf(d.y);
                    const f32x2 o = (pre * uu) * r;
                    pk[m][jp] = cvt_pk_bf16(o.x, o.y);
                    if (m == 0) { if (f0) { pF[2 * jp] = (f32x4){pre.x, G[m].x, uu.x, 0.f}; pF[2 * jp + 1] = (f32x4){pre.y, G[m].y, uu.y, 0.f}; } }
                    if (m == 3) { if (f15) { pL[2 * jp] = (f32x4){pre.x, G[m].x, uu.x, 0.f}; pL[2 * jp + 1] = (f32x4){pre.y, G[m].y, uu.y, 0.f}; } }
                }
            }
#pragma unroll
            for (int m = 0; m < 4; ++m) { u32x4 w; w.x = pk[m][0]; w.y = pk[m][1]; w.z = pk[m][2]; w.w = pk[m][3];
                __builtin_nontemporal_store(w, (u32x4*)(ACT + (size_t)(rbase + m * 16 + fr) * dff + gc0)); }
        }
    }
};

template <class Epi, class Sched, bool ALIGN_EPI = false, bool SP2 = false>
__device__ __forceinline__ void gemm_phase(PG8_LAS unsigned char* lds, const Gemm g, const Sched& S, const Epi& E) {
    const int tid = threadIdx.x, wid = __builtin_amdgcn_readfirstlane(tid >> 6), lane = tid & 63, wr = wid >> 2, wc = wid & 3, fr = lane & 15, fq = lane >> 4;
    const int K = g.K, nt = K / BK;
    unsigned voffA[2], voffB[2];
#pragma unroll
    for (int i = 0; i < 2; ++i) { int R, C; stage_rc(tid * 16 + i * 8192, R, C); const int Rb = Epi::PERM ? ((R & ~31) + perm32(R & 31)) : R;
        voffA[i] = (unsigned)(R * K + C) * 2u; voffB[i] = (unsigned)(Rb * K + C) * 2u; }
    const size_t kstep = (size_t)(BK * 2);
    const size_t hstep = (size_t)HALF * K * 2;
    const size_t tstep = 2 * hstep;
    const unsigned ldsw = (unsigned)wid * 1024u;
    const int aoff = lds_byte(wr * 64 + fr, fq * 8), boff = lds_byte(wc * 32 + fr, fq * 8);
#define PG8_SA(b, h) (((b) * 2 + (h)) * HTB)
#define PG8_SB(b, h) ((4 + (b) * 2 + (h)) * HTB)
#define PG8_STAGE(bufoff, gbase, voff) do { _Pragma("unroll") for (int _i = 0; _i < 2; ++_i) \
        __builtin_amdgcn_global_load_lds((const unsigned*)((const char*)(gbase) + (voff)[_i]), (PG8_LAS unsigned*)(lds + (bufoff) + ldsw + _i * 8192), 16, 0, 0); } while (0)
#define PG8_LDA(dst, b, h) do { _Pragma("unroll") for (int m = 0; m < 4; ++m) _Pragma("unroll") for (int k = 0; k < 2; ++k) dst[m][k] = *(const PG8_LAS bf16x8*)(lds + PG8_SA(b, h) + aoff + m * 2048 + k * 1024); } while (0)
#define PG8_LDB(dst, b, h) do { _Pragma("unroll") for (int n = 0; n < 2; ++n) _Pragma("unroll") for (int k = 0; k < 2; ++k) dst[n][k] = *(const PG8_LAS bf16x8*)(lds + PG8_SB(b, h) + boff + n * 2048 + k * 1024); } while (0)
#define PG8_MMA(ai, bj, At, Bt) do { __builtin_amdgcn_s_setprio(1); _Pragma("unroll") for (int m = 0; m < 4; ++m) _Pragma("unroll") for (int n = 0; n < 2; ++n) _Pragma("unroll") for (int k = 0; k < 2; ++k) \
        acc[ai][bj][m][n] = __builtin_amdgcn_mfma_f32_16x16x32_bf16(Bt[n][k], At[m][k], acc[ai][bj][m][n], 0, 0, 0); __builtin_amdgcn_s_setprio(0); } while (0)
#define PG8_WAIT_V(n) asm volatile("s_waitcnt vmcnt(" #n ")" ::: "memory")
#define PG8_WAIT_L(n) asm volatile("s_waitcnt lgkmcnt(" #n ")" ::: "memory")
#define PG8_BAR __builtin_amdgcn_s_barrier()
#define PG8_SCHED __builtin_amdgcn_sched_barrier(0)
    Unit cur, nxt; int ui = 0;
    if (!S.next(0, cur)) return;
    f32x4 acc[2][2][4][2];
#pragma unroll
    for (int a = 0; a < 2; ++a)
#pragma unroll
        for (int b = 0; b < 2; ++b)
#pragma unroll
            for (int m = 0; m < 4; ++m)
#pragma unroll
                for (int n = 0; n < 2; ++n) acc[a][b][m][n] = (f32x4){0.f, 0.f, 0.f, 0.f};
    bf16x8 At[4][2], B0[2][2], B1[2][2];
    const char* cA = (const char*)g.A + (size_t)cur.pm * tstep; const char* cB = (const char*)g.Bt + (size_t)cur.pn * tstep;
    S.a_ready(cur);
    if constexpr (SP2) {
        PG8_STAGE(PG8_SB(0, 0), cB, voffB); PG8_STAGE(PG8_SB(0, 1), cB + hstep, voffB); PG8_STAGE(PG8_SA(0, 0), cA, voffA); PG8_STAGE(PG8_SA(0, 1), cA + hstep, voffA);
        if (wr == 1) PG8_BAR;
        PG8_WAIT_V(2); PG8_BAR;
        PG8_STAGE(PG8_SB(1, 0), cB + kstep, voffB); PG8_STAGE(PG8_SA(1, 0), cA + kstep, voffA); PG8_STAGE(PG8_SB(1, 1), cB + hstep + kstep, voffB);
        PG8_WAIT_V(6); PG8_BAR;
    } else {
        PG8_STAGE(PG8_SB(0, 0), cB, voffB); PG8_STAGE(PG8_SA(0, 0), cA, voffA); PG8_STAGE(PG8_SB(0, 1), cB + hstep, voffB); PG8_STAGE(PG8_SA(0, 1), cA + hstep, voffA);
        if (wr == 1) PG8_BAR;
        PG8_WAIT_V(4); PG8_BAR;
        PG8_STAGE(PG8_SB(1, 0), cB + kstep, voffB); PG8_STAGE(PG8_SA(1, 0), cA + kstep, voffA); PG8_STAGE(PG8_SB(1, 1), cB + hstep + kstep, voffB);
        PG8_WAIT_V(6); PG8_BAR;
    }
    for (;;) {
        const bool has_next = S.next(ui + 1, nxt);
        const char* nA = has_next ? (const char*)g.A + (size_t)nxt.pm * tstep : cA; const char* nB = has_next ? (const char*)g.Bt + (size_t)nxt.pn * tstep : cB;
        for (int t = 0; t < nt; t += 2) {
            const bool last = (t == nt - 2);
            const char* a1 = cA + (size_t)(t + 1) * kstep;
            const char* a2 = last ? nA : cA + (size_t)(t + 2) * kstep; const char* b2 = last ? nB : cB + (size_t)(t + 2) * kstep;
            const char* a3 = a2 + kstep; const char* b3 = b2 + kstep;
            if (last && has_next) S.a_ready(nxt);
            if constexpr (SP2) {
            PG8_LDB(B0, 0, 0); PG8_LDB(B1, 0, 1); PG8_SCHED; PG8_LDA(At, 0, 0); PG8_STAGE(PG8_SA(1, 1), a1 + hstep, voffA);
            PG8_WAIT_V(8); PG8_WAIT_L(0); PG8_BAR; PG8_MMA(0, 0, At, B0); PG8_MMA(0, 1, At, B1); PG8_BAR; PG8_SCHED;
            PG8_LDA(At, 0, 1); PG8_STAGE(PG8_SB(0, 0), b2, voffB); PG8_STAGE(PG8_SB(0, 1), b2 + hstep, voffB); PG8_STAGE(PG8_SA(0, 0), a2, voffA);
            PG8_WAIT_V(8); PG8_WAIT_L(0); PG8_BAR; PG8_MMA(1, 0, At, B0); PG8_MMA(1, 1, At, B1); PG8_BAR; PG8_SCHED;
            PG8_LDB(B0, 1, 0); PG8_LDB(B1, 1, 1); PG8_SCHED; PG8_LDA(At, 1, 0); PG8_STAGE(PG8_SA(0, 1), a2 + hstep, voffA);
            PG8_WAIT_V(8); PG8_WAIT_L(0); PG8_BAR; PG8_MMA(0, 0, At, B0); PG8_MMA(0, 1, At, B1); PG8_BAR; PG8_SCHED;
            PG8_LDA(At, 1, 1); PG8_STAGE(PG8_SB(1, 0), b3, voffB); PG8_STAGE(PG8_SB(1, 1), b3 + hstep, voffB); PG8_STAGE(PG8_SA(1, 0), a3, voffA);
            PG8_WAIT_V(8); PG8_WAIT_L(0); PG8_BAR; PG8_MMA(1, 0, At, B0); PG8_MMA(1, 1, At, B1); PG8_BAR; PG8_SCHED;
            } else {
            PG8_LDB(B0, 0, 0); PG8_SCHED; PG8_LDA(At, 0, 0); PG8_STAGE(PG8_SA(1, 1), a1 + hstep, voffA);
            PG8_WAIT_L(8); PG8_BAR; PG8_WAIT_L(0); PG8_MMA(0, 0, At, B0); PG8_BAR; PG8_SCHED;
            PG8_LDB(B1, 0, 1); PG8_STAGE(PG8_SB(0, 0), b2, voffB);
            PG8_BAR; PG8_WAIT_L(0); PG8_MMA(0, 1, At, B1); PG8_BAR;
            PG8_LDA(At, 0, 1); PG8_STAGE(PG8_SA(0, 0), a2, voffA);
            PG8_BAR; PG8_WAIT_L(0); PG8_MMA(1, 0, At, B0); PG8_BAR; PG8_SCHED;
            PG8_STAGE(PG8_SB(0, 1), b2 + hstep, voffB);
            PG8_WAIT_V(6); PG8_BAR; PG8_MMA(1, 1, At, B1); PG8_BAR;
            PG8_LDB(B0, 1, 0); PG8_SCHED; PG8_LDA(At, 1, 0); PG8_STAGE(PG8_SA(0, 1), a2 + hstep, voffA);
            PG8_WAIT_L(8); PG8_BAR; PG8_WAIT_L(0); PG8_MMA(0, 0, At, B0); PG8_BAR; PG8_SCHED;
            PG8_LDB(B1, 1, 1); PG8_STAGE(PG8_SB(1, 0), b3, voffB);
            PG8_BAR; PG8_WAIT_L(0); PG8_MMA(0, 1, At, B1); PG8_BAR;
            PG8_LDA(At, 1, 1); PG8_STAGE(PG8_SA(1, 0), a3, voffA);
            PG8_BAR; PG8_WAIT_L(0); PG8_MMA(1, 0, At, B0); PG8_BAR; PG8_SCHED;
            PG8_STAGE(PG8_SB(1, 1), b3 + hstep, voffB);
            PG8_WAIT_V(6); PG8_BAR; PG8_MMA(1, 1, At, B1); PG8_BAR;
            }
        }
        if constexpr (ALIGN_EPI) { if (wr == 0) PG8_BAR; }
        if constexpr (!Epi::AFTER_DRAIN) { E(acc, cur, wr, wc, fr, fq); S.done(cur); }
        if (!has_next) break;
#pragma unroll
        for (int a = 0; a < 2; ++a)
#pragma unroll
            for (int b = 0; b < 2; ++b)
#pragma unroll
                for (int m = 0; m < 4; ++m)
#pragma unroll
                    for (int n = 0; n < 2; ++n) acc[a][b][m][n] = (f32x4){0.f, 0.f, 0.f, 0.f};
        cur = nxt; cA = nA; cB = nB; ++ui;
        if constexpr (ALIGN_EPI) { if (wr == 1) PG8_BAR; }
    }
    PG8_WAIT_V(0);
    if constexpr (!ALIGN_EPI) { if (wr == 0) PG8_BAR; }
    PG8_BAR;
    if constexpr (Epi::AFTER_DRAIN) { E.fused(acc, cur, wr, wc, fr, fq, lds, wid, lane); S.done(cur); }
#undef PG8_SA
#undef PG8_SB
#undef PG8_STAGE
#undef PG8_LDA
#undef PG8_LDB
#undef PG8_MMA
#undef PG8_WAIT_V
#undef PG8_WAIT_L
#undef PG8_BAR
#undef PG8_SCHED
}
}

#define GAS __attribute__((address_space(1)))
#define LAS __attribute__((address_space(3)))
typedef unsigned short bf16;
typedef unsigned v4u __attribute__((ext_vector_type(4)));
typedef unsigned v2u __attribute__((ext_vector_type(2)));
typedef float f32x4 __attribute__((ext_vector_type(4)));
typedef float f32x2 __attribute__((ext_vector_type(2)));
typedef float f32x16 __attribute__((ext_vector_type(16)));
typedef short bf16x8 __attribute__((ext_vector_type(8)));
typedef short s16x4 __attribute__((ext_vector_type(4)));

#ifndef MK_N_LAUNCHES
#define MK_N_LAUNCHES 1
#endif
constexpr int NPHASE = 13;
constexpr int NWAVES = 8, NTHR = 512;

constexpr int BATCH = 8, SEQ = 2048, DM = 2048, M = BATCH * SEQ;
constexpr int HW = 1024, NH = 8, DQK = 192, DNOPE = 128, DROPE = 64, DV = 128, QLR = 512, KVLR = 256;
constexpr int INW = 3 * HW + QLR + KVLR + DROPE, INWP = 4096;
constexpr int DFF = 5632, FE = 33, FH = 64;
constexpr int NQ = NH * DQK  , NKV = NH * (DNOPE + DV)  , AW = NH * DV  ;
constexpr float EPS = 1e-6f;
constexpr int KFLEN = 4112;

constexpr size_t MiB = 1u << 20;
constexpr size_t WS_CNT = 16384, WS_CNT2 = 32768, WS_SS1 = 65536, WS_SS2 = 131072, WS_SS3 = 196608, CTL_BYTES = 262144;
constexpr size_t WS_WIN = 1 * MiB, WS_WUQ = 17 * MiB, WS_WUKV = 19 * MiB, WS_WOUT = 20 * MiB, WS_WUP = 28 * MiB, WS_WDOWN = 72 * MiB;
constexpr size_t WS_H2 = 95 * MiB;
constexpr size_t WS_ROPE = 94 * MiB;
constexpr size_t WS_XN = 96 * MiB;
constexpr size_t WS_UT = 96 * MiB, WS_X0T = 128 * MiB;
constexpr size_t WS_PROJ = 160 * MiB;
constexpr size_t WS_MIXIN = 160 * MiB, WS_O = 224 * MiB, WS_MIXED = 256 * MiB;
constexpr size_t WS_CQN = 320 * MiB, WS_CKVN = 336 * MiB, WS_KPE = 344 * MiB, WS_KF = 346 * MiB;
constexpr size_t WS_Q = 356 * MiB, WS_KV = 404 * MiB;
constexpr size_t WS_YT = 468 * MiB;
constexpr size_t WS_ACT = 160 * MiB;
constexpr size_t WS_BB = 336 * MiB;
constexpr size_t WS_F = 96 * MiB;
constexpr size_t WS_H16 = 436 * MiB;
constexpr size_t WS_END = 500 * MiB;

constexpr int LDS_BYTES = 147456;

__device__ __forceinline__ unsigned f2bf(float f) { unsigned u = __builtin_bit_cast(unsigned, f); return (u + 0x7fffu + ((u >> 16) & 1u)) >> 16; }
__device__ __forceinline__ unsigned pk2(float lo, float hi) { return f2bf(lo) | (f2bf(hi) << 16); }
__device__ __forceinline__ float bflo(unsigned w) { return __builtin_bit_cast(float, w << 16); }
__device__ __forceinline__ float bfhi(unsigned w) { return __builtin_bit_cast(float, w & 0xffff0000u); }
__device__ __forceinline__ float bf1(bf16 h) { return __builtin_bit_cast(float, (unsigned)h << 16); }
#define LDS_WAIT() asm volatile("s_waitcnt lgkmcnt(0)" ::: "memory")
__device__ __forceinline__ float wave_sum(float v) {
#pragma unroll
    for (int o = 1; o < 64; o <<= 1) v += __shfl_xor(v, o);
    return v;
}
__device__ __forceinline__ void sincos_acc(float x, float& s, float& c) {
    const double xd = (double)x; const double k = rint(xd * 0.6366197723675814);
    const float y = (float)(xd - k * 1.5707963267948966); const int q = ((int)k) & 3;
    const float y2 = y * y;
    const float sp = y + y * y2 * (-1.6666654611e-1f + y2 * (8.3321608736e-3f + y2 * (-1.9515295891e-4f)));
    const float cp = 1.f - 0.5f * y2 + y2 * y2 * (4.166664568298827e-2f + y2 * (-1.388731625493765e-3f + y2 * 2.443315711809948e-5f));
    const float s0 = (q & 1) ? cp : sp, c0 = (q & 1) ? sp : cp;
    s = (q & 2) ? -s0 : s0; c = ((q + 1) & 2) ? -c0 : c0;
}

#define XB_TMO      128
#define XB_XCNT(j)  (256  + 64 * (j))
#define XB_XSUB(j)  (1280 + 64 * (j))
#define XB_XGEN(j)  (2304 + 64 * (j))
#define XB_TOP      3328
#define XB_TOPGEN   3392
#define XCD_BAR_WORDS 3456
#define XB_SPIN_CAP (1u << 18)

__device__ __forceinline__ unsigned xb_ld(unsigned* p)              { return __hip_atomic_load(p, __ATOMIC_RELAXED, __HIP_MEMORY_SCOPE_AGENT); }
__device__ __forceinline__ unsigned xb_add(unsigned* p, unsigned v) { return __hip_atomic_fetch_add(p, v, __ATOMIC_RELAXED, __HIP_MEMORY_SCOPE_AGENT); }
__device__ __forceinline__ unsigned xb_xcc_id() { return (unsigned)__builtin_amdgcn_s_getreg((3 << 11) | 20) & 0xFu; }
#define XB_SPIN(cond, bar) do { unsigned _sp = 0; while (cond) { __builtin_amdgcn_s_sleep(1); \
    if ((++_sp & 255u) == 0u) { if (xb_ld(&(bar)[XB_TMO])) break; if (_sp > XB_SPIN_CAP) { atomicAdd(&(bar)[XB_TMO], 1u); break; } } } } while (0)

struct XcdBarrier {
    unsigned* bar; unsigned x;
    volatile LAS unsigned* st;
};

__device__ __forceinline__ XcdBarrier xcd_barrier_post(unsigned* bar, volatile LAS unsigned* st) {
    XcdBarrier b; b.bar = bar; b.x = xb_xcc_id(); b.st = st;
    if (threadIdx.x == 0) (void)xb_add(&bar[XB_XCNT(b.x)], 1u);
    return b;
}
__device__ __forceinline__ void xcd_barrier_complete(unsigned* bar, unsigned x, unsigned& nloc, unsigned& nx) {
    const unsigned G = gridDim.x * gridDim.y * gridDim.z;
    unsigned sum, cnt, mine, sp = 0u;
    for (;;) {
        sum = 0u; cnt = 0u; mine = 0u;
#pragma unroll
        for (unsigned j = 0; j < 16; ++j) { const unsigned c = xb_ld(&bar[XB_XCNT(j)]); sum += c; cnt += (c > 0u) ? 1u : 0u; mine = (j == x) ? c : mine; }
        if (sum == G) break;
        __builtin_amdgcn_s_sleep(1);
        if ((++sp & 255u) == 0u) { if (xb_ld(&bar[XB_TMO])) break; if (sp > XB_SPIN_CAP) { atomicAdd(&bar[XB_TMO], 1u); break; } }
    }
    nloc = mine > 0u ? mine : 1u; nx = cnt > 0u ? cnt : 1u;
}

__device__ __forceinline__ void xcd_barrier(const XcdBarrier& b) {
    asm volatile("s_waitcnt vmcnt(0)" ::: "memory");
    __syncthreads();
    if (threadIdx.x == 0) {
        unsigned* bar = b.bar;
        __builtin_amdgcn_s_waitcnt(0);
        unsigned nloc = b.st[0], nx = b.st[1];
        if (nloc == 0u) { xcd_barrier_complete(bar, b.x, nloc, nx); b.st[0] = nloc; b.st[1] = nx; }
        const unsigned old = xb_add(&bar[XB_XSUB(b.x)], 1u);
        const unsigned gen = old / nloc;
        if (old + 1u == (gen + 1u) * nloc) {
            __builtin_amdgcn_fence(__ATOMIC_RELEASE, "agent");
            asm volatile("s_waitcnt vmcnt(0)" ::: "memory");
            const unsigned og = xb_add(&bar[XB_TOP], 1u);
            const unsigned tg = og / nx;
            if (og + 1u != (tg + 1u) * nx) XB_SPIN(xb_ld(&bar[XB_TOP]) < (tg + 1u) * nx, bar);
            __builtin_amdgcn_fence(__ATOMIC_ACQUIRE, "agent");
            asm volatile("s_waitcnt vmcnt(0)" ::: "memory");
        } else {
            XB_SPIN(xb_ld(&bar[XB_TOP]) < (gen + 1u) * nx, bar);
            __builtin_amdgcn_fence(__ATOMIC_ACQUIRE, "agent");
            asm volatile("s_waitcnt vmcnt(0)" ::: "memory");
        }
    }
    __syncthreads();
}

struct Frame {
    LAS unsigned char* lds; char* ldsg;
    int tid, lane, wave, vcu, G;
    const float* in[27]; float* out; unsigned char* ws;
};

__device__ __forceinline__ void p0_transpose_item(const float* W, int K, int N, bf16* WT, int k0, int n0, int drow0, LAS float* scr, int lane, const float* kscale) {
    f32x4 v[8];
#pragma unroll
    for (int i = 0; i < 8; ++i) v[i] = __builtin_nontemporal_load((const f32x4*)(W + (size_t)(k0 + (lane >> 3) + 8 * i) * N + n0 + (lane & 7) * 4));
#pragma unroll
    for (int i = 0; i < 8; ++i) { LAS float* d = scr + ((lane >> 3) + 8 * i) * 33 + (lane & 7) * 4; d[0] = v[i].x; d[1] = v[i].y; d[2] = v[i].z; d[3] = v[i].w; }
    LDS_WAIT(); asm volatile("" ::: "memory");
    const int c = lane & 7;
    float ks[8];
#pragma unroll
    for (int e = 0; e < 8; ++e) ks[e] = kscale ? kscale[k0 + 8 * c + e] : 1.f;
#pragma unroll
    for (int j = 0; j < 4; ++j) { const int n = (lane >> 3) + 8 * j; const LAS float* s = scr + (8 * c) * 33 + n;
        v4u o; o.x = pk2(s[0 * 33] * ks[0], s[1 * 33] * ks[1]); o.y = pk2(s[2 * 33] * ks[2], s[3 * 33] * ks[3]); o.z = pk2(s[4 * 33] * ks[4], s[5 * 33] * ks[5]); o.w = pk2(s[6 * 33] * ks[6], s[7 * 33] * ks[7]);
        if (kscale || K == DFF || N == DM) __builtin_nontemporal_store(o, (v4u*)(WT + (size_t)(drow0 + n) * K + k0 + 8 * c));
        else *(GAS v4u*)(WT + (size_t)(drow0 + n) * K + k0 + 8 * c) = o; }
    LDS_WAIT(); asm volatile("" ::: "memory");
}
__device__ __forceinline__ void p0_transpose_mat(Frame& F, const float* W, int K, int N, bf16* WT, bool upmap, const float* kscale = nullptr) {
    LAS float* scr = (LAS float*)(F.lds + F.wave * 16384);
    const int gw = F.vcu * NWAVES + F.wave, NGW = F.G * NWAVES; const int nblk = N / 32, nitems = (K / 64) * nblk;
    for (int it = gw; it < nitems; it += NGW) { const int kb = it / nblk, nb = it % nblk, n0 = 32 * nb;
        int drow0 = n0;
        if (upmap) drow0 = (n0 < DFF) ? (n0 >> 7) * 256 + (n0 & 127) : ((n0 - DFF) >> 7) * 256 + 128 + ((n0 - DFF) & 127);
        p0_transpose_item(W, K, N, WT, 64 * kb, n0, drow0, scr, F.lane, kscale); }
}
__device__ __forceinline__ void rms_row_to_bf16(const float* xrow, const float* gain, bf16* orow, int lane) {
    f32x4 v[8]; float s = 0.f;
#pragma unroll
    for (int j = 0; j < 8; ++j) { v[j] = __builtin_nontemporal_load((const f32x4*)(xrow + 4 * (lane + 64 * j))); s += (v[j].x * v[j].x + v[j].y * v[j].y) + (v[j].z * v[j].z + v[j].w * v[j].w); }
    const float r = 1.f / sqrtf(wave_sum(s) * (1.f / DM) + EPS);
#pragma unroll
    for (int j = 0; j < 8; ++j) { const f32x4 g = *(const f32x4*)(gain + 4 * (lane + 64 * j));
        v2u o; o.x = pk2(v[j].x * r * g.x, v[j].y * r * g.y); o.y = pk2(v[j].z * r * g.z, v[j].w * r * g.w);
        *(v2u*)(orow + 4 * (lane + 64 * j)) = o; }
}
__device__ __forceinline__ void p0_filter_hidden(Frame& F) {
    LAS float* Z = (LAS float*)F.lds;
    LAS float* H1 = Z + 8 * 33;
    const float *w1 = F.in[5], *b1 = F.in[6], *fr1 = F.in[7], *w2 = F.in[8], *b2 = F.in[9], *fr2 = F.in[10];
    float* H2G = (float*)(F.ws + WS_H2);
    const int tid = F.tid;
    for (int unit = F.vcu; unit < SEQ / 8; unit += F.G) {
        const int l0 = unit * 8;
        __syncthreads();
        if (tid < 8 * 33) { const int l = l0 + tid / 33, f = tid % 33; float v;
            if (f == 0) v = (float)l * (1.0f / (float)(SEQ - 1));
            else { const int j = (f - 1) & 15; const float w = 6.283185307179586f * (float)l / (float)SEQ; const float fj = 1e-4f + (float)j * ((15.0f - 1e-4f) / 15.0f);
                float s, c; sincos_acc(w * fj, s, c); v = (f <= 16) ? c : -s; }
            Z[tid] = v; }
        __syncthreads();
        const int l = tid >> 6, k = tid & 63;
        { float a = b1[k];
#pragma unroll
          for (int f = 0; f < FE; ++f) a += Z[l * 33 + f] * w1[f * FH + k];
          float s, c; sincos_acc(fr1[k] * a, s, c); H1[l * 65 + k] = s; }
        __syncthreads();
        { float a = b2[k];
#pragma unroll 16
          for (int j = 0; j < FH; ++j) a += H1[l * 65 + j] * w2[j * FH + k];
          float s, c; sincos_acc(fr2[k] * a, s, c); H2G[(size_t)(l0 + l) * FH + k] = s; }
    }
    __syncthreads();
}
__device__ __forceinline__ void p2_filter_out(Frame& F) {
    LAS float* H2 = (LAS float*)F.lds;
    LAS float* W3 = H2 + 64 * 65 + 12;
    const float* w3 = F.in[11]; const float* H2G = (const float*)(F.ws + WS_H2);
    bf16* KF = (bf16*)(F.ws + WS_KF);
    const int tid = F.tid;
    for (int i = F.vcu * NTHR + tid; i < HW * 17; i += F.G * NTHR) KF[(size_t)(i / 17) * KFLEN + (i % 17)] = 0;
    for (int unit = F.vcu; unit < 32 * 16; unit += F.G) {
        const int l0 = (unit >> 4) * 64, n0 = (unit & 15) * 128;
        __syncthreads();
#pragma unroll
        for (int i = 0; i < 2; ++i) { const int id = tid + NTHR * i; const int l = id >> 4, k4 = (id & 15) * 4; const f32x4 v = *(const f32x4*)(H2G + (size_t)(l0 + l) * FH + k4);
            LAS float* d = H2 + l * 65 + k4; d[0] = v.x; d[1] = v.y; d[2] = v.z; d[3] = v.w; }
#pragma unroll
        for (int i = 0; i < 4; ++i) { const int id = tid + NTHR * i; const int k = id >> 5, c4 = (id & 31) * 4;
            *(LAS f32x4*)(W3 + k * 128 + c4) = *(const f32x4*)(w3 + (size_t)k * (2 * HW) + n0 + c4); }
        __syncthreads();
        { const int l = tid & 63, ng = __builtin_amdgcn_readfirstlane(tid >> 6); const int nb = n0 + ng * 16;
          float acc[16];
#pragma unroll
          for (int i = 0; i < 16; ++i) acc[i] = 0.f;
#pragma unroll 4
          for (int k = 0; k < FH; ++k) { const float h = H2[l * 65 + k]; const LAS f32x4* wr = (const LAS f32x4*)(W3 + k * 128 + ng * 16);
#pragma unroll
              for (int q = 0; q < 4; ++q) { const f32x4 wv = wr[q]; acc[4 * q] += h * wv.x; acc[4 * q + 1] += h * wv.y; acc[4 * q + 2] += h * wv.z; acc[4 * q + 3] += h * wv.w; } }
          const int lg = l0 + l; const float tl = (float)lg * (1.0f / (float)(SEQ - 1));
          const float mind = -3.0701134573253945f, maxd = -15.350567286626973f;
#pragma unroll
          for (int i = 0; i < 16; ++i) { const int n = nb + i, dir = n >> 10, c = n & 1023;
              const float delta = fabsf(mind + (float)c * ((maxd - mind) / 1023.0f));
              const float win = __expf(-tl * delta) + 0.05f; const float v = acc[i] * win;
              if (dir == 0) KF[(size_t)c * KFLEN + 16 + 2048 - lg] = (bf16)f2bf(v);
              else if (lg > 0) KF[(size_t)c * KFLEN + 16 + 2048 + lg] = (bf16)f2bf(v); }
        }
    }
    __syncthreads();
}
__device__ __forceinline__ void p0_prologue(Frame& F) {
    unsigned char* ws = F.ws;
    p0_transpose_mat(F, F.in[2], DM, INW, (bf16*)(ws + WS_WIN), false);
    p0_transpose_mat(F, F.in[14], QLR, NQ, (bf16*)(ws + WS_WUQ), false);
    p0_transpose_mat(F, F.in[16], KVLR, NKV, (bf16*)(ws + WS_WUKV), false);
    p0_transpose_mat(F, F.in[19], DM, DM, (bf16*)(ws + WS_WOUT), false);
    p0_transpose_mat(F, F.in[22], DM, 2 * DFF, (bf16*)(ws + WS_WUP), true, F.in[21]);
    p0_transpose_mat(F, F.in[25], DFF, DM, (bf16*)(ws + WS_WDOWN), false);
    const int gw = F.vcu * NWAVES + F.wave, NGW = F.G * NWAVES;
    bf16* XN = (bf16*)(ws + WS_XN);
    for (int m = gw; m < M; m += NGW) rms_row_to_bf16(F.in[0] + (size_t)m * DM, F.in[1], XN + (size_t)m * DM, F.lane);
}
__device__ __forceinline__ void p0_pre(Frame& F) {
    f32x2* ROPE = (f32x2*)(F.ws + WS_ROPE);
    for (int i = F.vcu * NTHR + F.tid; i < SEQ * 32; i += F.G * NTHR) { const int s = i >> 5, j = i & 31;
        const float invf = 1.0f / powf(10000.0f, (float)(2 * j) / 64.0f); const float ang = (float)s * invf;
        float sn, cs; sincos_acc(ang, sn, cs); ROPE[i] = (f32x2){cs, sn}; }
    p0_filter_hidden(F);
}

__device__ __forceinline__ void p2_hyena_prep(Frame& F) {
    constexpr int TP = 72;
    LAS bf16* TB = (LAS bf16*)F.lds;
    const bf16* PROJ = (const bf16*)(F.ws + WS_PROJ); bf16* UT = (bf16*)(F.ws + WS_UT); bf16* X0T = (bf16*)(F.ws + WS_X0T);
    const float* cw = F.in[3]; const float* cb = F.in[4];
    const int tid = F.tid, ch = tid & 7, sl = tid >> 3;
    int it = 0;
    for (int unit = F.vcu; unit < BATCH * 32 * 16; unit += F.G, ++it) {
        const int ct = unit & 15, st = (unit >> 4) & 31, b = unit >> 9; const int c0 = ct * 64 + ch * 8, s = st * 64 + sl;
        v4u w[3][3];
#pragma unroll
        for (int a = 0; a < 3; ++a)
#pragma unroll
            for (int j = 0; j < 3; ++j) { const int ss = s - 1 + j; w[a][j] = (v4u){0u, 0u, 0u, 0u};
                if (ss >= 0 && ss < SEQ) w[a][j] = *(const v4u*)(PROJ + (size_t)(b * SEQ + ss) * INWP + a * HW + c0); }
        float val[3][8];
#pragma unroll
        for (int a = 0; a < 3; ++a) { const float* wp = cw + a * HW + c0;
            const f32x4 k0a = *(const f32x4*)(wp), k0b = *(const f32x4*)(wp + 4), k1a = *(const f32x4*)(wp + 3 * HW), k1b = *(const f32x4*)(wp + 3 * HW + 4);
            const f32x4 k2a = *(const f32x4*)(wp + 6 * HW), k2b = *(const f32x4*)(wp + 6 * HW + 4), bba = *(const f32x4*)(cb + a * HW + c0), bbb = *(const f32x4*)(cb + a * HW + c0 + 4);
            const float k0[8] = {k0a.x, k0a.y, k0a.z, k0a.w, k0b.x, k0b.y, k0b.z, k0b.w}, k1[8] = {k1a.x, k1a.y, k1a.z, k1a.w, k1b.x, k1b.y, k1b.z, k1b.w};
            const float k2[8] = {k2a.x, k2a.y, k2a.z, k2a.w, k2b.x, k2b.y, k2b.z, k2b.w}, bb[8] = {bba.x, bba.y, bba.z, bba.w, bbb.x, bbb.y, bbb.z, bbb.w};
            const unsigned r0[4] = {w[a][0].x, w[a][0].y, w[a][0].z, w[a][0].w}, r1[4] = {w[a][1].x, w[a][1].y, w[a][1].z, w[a][1].w}, r2[4] = {w[a][2].x, w[a][2].y, w[a][2].z, w[a][2].w};
#pragma unroll
            for (int k = 0; k < 4; ++k) {
                val[a][2 * k] = k0[2 * k] * bflo(r0[k]) + k1[2 * k] * bflo(r1[k]) + k2[2 * k] * bflo(r2[k]) + bb[2 * k];
                val[a][2 * k + 1] = k0[2 * k + 1] * bfhi(r0[k]) + k1[2 * k + 1] * bfhi(r1[k]) + k2[2 * k + 1] * bfhi(r2[k]) + bb[2 * k + 1]; } }
        LAS bf16* Tu = TB + (it & 1) * (2 * 64 * TP); LAS bf16* Tx = Tu + 64 * TP;
#pragma unroll
        for (int e = 0; e < 8; ++e) { Tu[(ch * 8 + e) * TP + sl] = (bf16)f2bf(val[1][e] * val[2][e]); Tx[(ch * 8 + e) * TP + sl] = (bf16)f2bf(val[0][e]); }
        __syncthreads();
        { const int c = tid >> 3, pc = tid & 7; const size_t o = ((size_t)(ct * 64 + c) * BATCH + b) * SEQ + st * 64 + pc * 8;
          *(v4u*)(UT + o) = *(const LAS v4u*)(Tu + c * TP + pc * 8); *(v4u*)(X0T + o) = *(const LAS v4u*)(Tx + c * TP + pc * 8); }
    }
    __syncthreads();
}
__device__ __forceinline__ void p2_mla_prep(Frame& F) {
    const bf16* PROJ = (const bf16*)(F.ws + WS_PROJ); bf16* CQN = (bf16*)(F.ws + WS_CQN); bf16* CKVN = (bf16*)(F.ws + WS_CKVN); bf16* KPE = (bf16*)(F.ws + WS_KPE);
    const f32x2* ROPE = (const f32x2*)(F.ws + WS_ROPE);
    const float* gq = F.in[13]; const float* gkv = F.in[15];
    const int gw = F.vcu * NWAVES + F.wave, NGW = F.G * NWAVES, lane = F.lane;
    const f32x4 gq0 = *(const f32x4*)(gq + 8 * lane), gq1 = *(const f32x4*)(gq + 8 * lane + 4), gk0 = *(const f32x4*)(gkv + 4 * lane);
    constexpr int UR = 2;
    for (int m0 = gw; m0 < M; m0 += NGW * UR) {
        v4u wq[UR]; v2u wk[UR]; bf16 xp[UR]; f32x2 cs[UR];
#pragma unroll
        for (int u = 0; u < UR; ++u) { const int m = m0 + u * NGW; const bf16* row = PROJ + (size_t)m * INWP;
            wq[u] = __builtin_nontemporal_load((const v4u*)(row + 3 * HW + 8 * lane)); wk[u] = __builtin_nontemporal_load((const v2u*)(row + 3 * HW + QLR + 4 * lane));
            xp[u] = row[3 * HW + QLR + KVLR + lane]; cs[u] = ROPE[(m & (SEQ - 1)) * 32 + (lane & 31)]; }
#pragma unroll
        for (int u = 0; u < UR; ++u) { const int m = m0 + u * NGW;
            { const v4u w = wq[u];
              float v[8] = {bflo(w.x), bfhi(w.x), bflo(w.y), bfhi(w.y), bflo(w.z), bfhi(w.z), bflo(w.w), bfhi(w.w)}; float s = 0.f;
#pragma unroll
              for (int i = 0; i < 8; ++i) s += v[i] * v[i];
              const float r = 1.f / sqrtf(wave_sum(s) * (1.f / QLR) + EPS);
              v4u o; o.x = pk2(v[0] * r * gq0.x, v[1] * r * gq0.y); o.y = pk2(v[2] * r * gq0.z, v[3] * r * gq0.w); o.z = pk2(v[4] * r * gq1.x, v[5] * r * gq1.y); o.w = pk2(v[6] * r * gq1.z, v[7] * r * gq1.w);
              *(v4u*)(CQN + (size_t)m * QLR + 8 * lane) = o; }
            { const v2u w = wk[u];
              float v[4] = {bflo(w.x), bfhi(w.x), bflo(w.y), bfhi(w.y)}; float s = (v[0] * v[0] + v[1] * v[1]) + (v[2] * v[2] + v[3] * v[3]);
              const float r = 1.f / sqrtf(wave_sum(s) * (1.f / KVLR) + EPS);
              v2u o; o.x = pk2(v[0] * r * gk0.x, v[1] * r * gk0.y); o.y = pk2(v[2] * r * gk0.z, v[3] * r * gk0.w);
              *(v2u*)(CKVN + (size_t)m * KVLR + 4 * lane) = o; }
            { const float x = bf1(xp[u]); const float p = __shfl_xor(x, 32);
              const float o = x * cs[u].x + ((lane < 32) ? -p : p) * cs[u].y;
              KPE[(size_t)m * DROPE + lane] = (bf16)f2bf(o); } }
    }
}

constexpr int US_PITCH = 2120;
constexpr int KFP = 4120;
__device__ __forceinline__ bf16x8 hy_afrag(const LAS bf16* FC, int a, int i, int quad) {
    const int sh = i & 7;
    return *(const LAS bf16x8*)(FC + sh * KFP + (16 + 2048 - 32 * a + quad * 8 - (i - sh)));
}
__device__ __forceinline__ void p4_longconv(Frame& F) {
    LAS bf16* FL = (LAS bf16*)F.lds;
    LAS bf16* US = (LAS bf16*)(F.lds + 66048);
    const bf16* KF = (const bf16*)(F.ws + WS_KF); const bf16* UT = (const bf16*)(F.ws + WS_UT); const bf16* X0T = (const bf16*)(F.ws + WS_X0T); bf16* YT = (bf16*)(F.ws + WS_YT);
    const float* hbias = F.in[12];
    const int tid = F.tid, lane = F.lane, w = F.wave, i16 = lane & 15, quad = lane >> 4, batch = lane & 7, g = (lane >> 3) & 1;
    for (int c = F.vcu; c < HW; c += F.G) {
        __syncthreads();
        { v4u kf[9], us[4];
#pragma unroll
          for (int i = 0; i < 9; ++i) { const int id = tid + NTHR * i; const int sh = id & 7, ck = (id >> 3) + 1;
              kf[i] = (v4u){0u, 0u, 0u, 0u}; if (id < 8 * 513) __builtin_memcpy(&kf[i], (const char*)(KF + (size_t)c * KFLEN + ck * 8 - sh), 16); }
#pragma unroll
          for (int i = 0; i < 4; ++i) { const int id = tid + NTHR * i; const int b = id >> 8, ch = id & 255;
              us[i] = __builtin_nontemporal_load((const v4u*)(UT + ((size_t)c * BATCH + b) * SEQ + ch * 8)); }
#pragma unroll
          for (int i = 0; i < 9; ++i) { const int id = tid + NTHR * i; const int sh = id & 7, ck = (id >> 3) + 1; if (id < 8 * 513) *(LAS v4u*)(FL + sh * KFP + ck * 8) = kf[i]; }
#pragma unroll
          for (int i = 0; i < 4; ++i) { const int id = tid + NTHR * i; const int b = id >> 8, ch = id & 255; *(LAS v4u*)(US + b * US_PITCH + 32 + ch * 8) = us[i]; } }
        for (int id = tid; id < 8 * 9; id += NTHR) { const int b = id / 9, ch = id % 9;
            const int off = (ch < 4) ? ch * 8 : 32 + 2048 + (ch - 4) * 8; *(LAS v4u*)(US + b * US_PITCH + off) = (v4u){0u, 0u, 0u, 0u}; }
        __syncthreads();
        f32x4 acc[8]; bf16x8 ar[8];
#pragma unroll
        for (int p = 0; p < 8; ++p) acc[p] = (f32x4){0.f, 0.f, 0.f, 0.f};
#pragma unroll
        for (int p = 0; p < 8; ++p) ar[p] = hy_afrag(FL, 8 * w + p + 1, i16, quad);
        const LAS bf16* ub = US + batch * US_PITCH + 32 + 16 * g + quad * 8;
        bf16x8 bcur = *(const LAS bf16x8*)(ub - 32);
        for (int J = 0; J < 9; ++J) {
#pragma unroll
            for (int jj8 = 0; jj8 < 8; ++jj8) {
                const int jj = J * 8 + jj8;
                if (jj < 65) {
                    const int j = jj - 1; const bool more = (jj + 1 < 65);
                    bf16x8 bnext = bcur, anext = ar[(7 - jj8) & 7];
                    if (more) { bnext = *(const LAS bf16x8*)(ub + 32 * (j + 1)); anext = hy_afrag(FL, 8 * w - (j + 1), i16, quad); }
#pragma unroll
                    for (int p = 0; p < 8; ++p) acc[p] = __builtin_amdgcn_mfma_f32_16x16x32_bf16(ar[(p - jj8) & 7], bcur, acc[p], 0, 0, 0);
                    ar[(7 - jj8) & 7] = anext; bcur = bnext;
                }
            }
        }
        const float hb = hbias[c];
#pragma unroll
        for (int p = 0; p < 8; ++p) { const int t = 32 * (8 * w + p) + 16 * g + quad * 4;
            const size_t o = ((size_t)c * BATCH + batch) * SEQ + t;
            const v2u xw = __builtin_nontemporal_load((const v2u*)(X0T + o)); const v2u uw = *(const LAS v2u*)(US + batch * US_PITCH + 32 + t);
            const float y0 = bflo(xw.x) * (acc[p][0] + hb * bflo(uw.x)), y1 = bfhi(xw.x) * (acc[p][1] + hb * bfhi(uw.x));
            const float y2 = bflo(xw.y) * (acc[p][2] + hb * bflo(uw.y)), y3 = bfhi(xw.y) * (acc[p][3] + hb * bfhi(uw.y));
            v2u ov; ov.x = pk2(y0, y1); ov.y = pk2(y2, y3); *(v2u*)(YT + o) = ov; }
    }
    __syncthreads();
}

namespace att {
constexpr int QBLK = 32, KVBLK = 64;
constexpr float SCALE = 0.07216878364870322f;
constexpr float THR = 8.f;
constexpr int SHM_V = KVBLK * DV * 2  , SHM_K = KVBLK * DQK * 2  , SHM_ATTN = 2 * SHM_V + 2 * SHM_K + NWAVES * 64 * 4;
#define KSWZ(row, colB) ((row) * 384 + ((colB) ^ ((((row) >> 1) & 7) << 4)))
#define SBAR() __builtin_amdgcn_sched_barrier(0)
__device__ __forceinline__ int crow(int r, int hi) { return (r & 3) + 8 * (r >> 2) + 4 * hi; }
__device__ __forceinline__ unsigned cvtpk(float lo, float hi) { unsigned r; asm volatile("v_cvt_pk_bf16_f32 %0, %1, %2" : "=v"(r) : "v"(lo), "v"(hi)); return r; }
__device__ __forceinline__ void partialSM(f32x16& p0, f32x16& p1, float& m_reg, float& mn, float& alpha) {
  constexpr float C = SCALE * 1.4426950408889634f;
  float pmax = p0[0];
#pragma unroll
  for (int r = 1; r < 16; ++r) pmax = fmaxf(pmax, p0[r]);
#pragma unroll
  for (int r = 0; r < 16; ++r) pmax = fmaxf(pmax, p1[r]);
  { auto rr = __builtin_amdgcn_permlane32_swap(__float_as_uint(pmax), __float_as_uint(pmax), false, false);
    pmax = fmaxf(__uint_as_float(rr[0]), __uint_as_float(rr[1])); }
  if (__builtin_expect(__all(pmax - m_reg <= THR / SCALE), 1)) { mn = m_reg; alpha = 1.f; }
  else { mn = fmaxf(m_reg, pmax); alpha = __builtin_amdgcn_exp2f((m_reg - mn) * C); m_reg = mn; }
  float mnC = -mn * C;
#pragma unroll
  for (int r = 0; r < 16; ++r) p0[r] = fmaf(p0[r], C, mnC);
#pragma unroll
  for (int r = 0; r < 16; ++r) p1[r] = fmaf(p1[r], C, mnC);
#pragma unroll
  for (int r = 0; r < 16; ++r) p0[r] = __builtin_amdgcn_exp2f(p0[r]);
}
__device__ __forceinline__ void finishSM(f32x16& p0, f32x16& p1, float alpha, float& l_reg, bf16x8& pa0, bf16x8& pa1, bf16x8& pa2, bf16x8& pa3) {
#pragma unroll
  for (int r = 0; r < 16; ++r) p1[r] = __builtin_amdgcn_exp2f(p1[r]);
  float ps = 0;
#pragma unroll
  for (int r = 0; r < 16; ++r) ps += p0[r];
#pragma unroll
  for (int r = 0; r < 16; ++r) ps += p1[r];
  { auto rr = __builtin_amdgcn_permlane32_swap(__float_as_uint(ps), __float_as_uint(ps), false, false);
    ps = __uint_as_float(rr[0]) + __uint_as_float(rr[1]); }
  l_reg = l_reg * alpha + ps;
#define PK4(P, BASE, OUT) do { unsigned a0 = cvtpk(P[BASE + 0], P[BASE + 1]), a1 = cvtpk(P[BASE + 2], P[BASE + 3]);   \
    unsigned b0 = cvtpk(P[BASE + 4], P[BASE + 5]), b1 = cvtpk(P[BASE + 6], P[BASE + 7]);                              \
    auto r0 = __builtin_amdgcn_permlane32_swap(a0, b0, false, false); auto r1 = __builtin_amdgcn_permlane32_swap(a1, b1, false, false); \
    v4u w = {r0[0], r1[0], r0[1], r1[1]}; OUT = __builtin_bit_cast(bf16x8, w); } while (0)
  PK4(p0, 0, pa0); PK4(p0, 8, pa1); PK4(p1, 0, pa2); PK4(p1, 8, pa3);
#undef PK4
}
__device__ __forceinline__ void qkt(f32x16& p0, f32x16& p1, const char* Ks, const bf16x8* qr, int r32, int hi) {
  p0 = f32x16{}; p1 = f32x16{};
#pragma unroll
  for (int d0 = 0; d0 < 12; ++d0) { int cb = (d0 * 16 + hi * 8) * 2;
    bf16x8 b0 = *reinterpret_cast<const bf16x8*>(Ks + KSWZ(r32, cb));
    bf16x8 b1 = *reinterpret_cast<const bf16x8*>(Ks + KSWZ(32 + r32, cb));
    p0 = __builtin_amdgcn_mfma_f32_32x32x16_bf16(b0, qr[d0], p0, 0, 0, 0);
    p1 = __builtin_amdgcn_mfma_f32_32x32x16_bf16(b1, qr[d0], p1, 0, 0, 0); }
}
__device__ __forceinline__ int v_st(int k, int c) { const int kk = (k & ~0xC) | ((k & 4) << 1) | ((k & 8) >> 1); return ((kk >> 3) * 4 + (c >> 5)) * 512 + ((kk & 7) * 32 + (c & 31)) * 2; }
__device__ __forceinline__ int v_rd_base(int lane) { return ((lane & 3) << 3) | (((lane >> 2) & 3) << 6) | (((lane >> 4) & 1) << 5) | (((lane >> 5) & 1) << 8); }
constexpr int v_rd_off(int d0, int ks, int half) { return d0 * 512 + ks * 4096 + half * 2048; }
template <int OFF> __device__ __forceinline__ s16x4 tr_read(int vb) {
  s16x4 r; asm volatile("ds_read_b64_tr_b16 %0, %1 offset:%2" : "=&v"(r) : "v"(vb), "i"(OFF) : "memory"); return r;
}
template <int D0> __device__ __forceinline__ void pv_one(f32x16& od, int vb, bf16x8 pa0, bf16x8 pa1, bf16x8 pa2, bf16x8 pa3) {
  const s16x4 l0 = tr_read<v_rd_off(D0, 0, 0)>(vb), h0 = tr_read<v_rd_off(D0, 0, 1)>(vb), l1 = tr_read<v_rd_off(D0, 1, 0)>(vb), h1 = tr_read<v_rd_off(D0, 1, 1)>(vb);
  const s16x4 l2 = tr_read<v_rd_off(D0, 2, 0)>(vb), h2 = tr_read<v_rd_off(D0, 2, 1)>(vb), l3 = tr_read<v_rd_off(D0, 3, 0)>(vb), h3 = tr_read<v_rd_off(D0, 3, 1)>(vb);
  asm volatile("s_waitcnt lgkmcnt(0)" ::: "memory"); SBAR();
#define PK(L, H) (bf16x8){L[0], L[1], L[2], L[3], H[0], H[1], H[2], H[3]}
  od = __builtin_amdgcn_mfma_f32_32x32x16_bf16(pa0, PK(l0, h0), od, 0, 0, 0);
  od = __builtin_amdgcn_mfma_f32_32x32x16_bf16(pa1, PK(l1, h1), od, 0, 0, 0);
  od = __builtin_amdgcn_mfma_f32_32x32x16_bf16(pa2, PK(l2, h2), od, 0, 0, 0);
  od = __builtin_amdgcn_mfma_f32_32x32x16_bf16(pa3, PK(l3, h3), od, 0, 0, 0);
#undef PK
}
__device__ __forceinline__ void pv_d0(f32x16* o, int vb, bf16x8 pa0, bf16x8 pa1, bf16x8 pa2, bf16x8 pa3) {
  pv_one<0>(o[0], vb, pa0, pa1, pa2, pa3); pv_one<1>(o[1], vb, pa0, pa1, pa2, pa3); pv_one<2>(o[2], vb, pa0, pa1, pa2, pa3); pv_one<3>(o[3], vb, pa0, pa1, pa2, pa3);
}
__device__ __forceinline__ void attn_unit(const bf16* __restrict__ Qb, const bf16* __restrict__ KVh, const bf16* __restrict__ KPb, bf16* __restrict__ Ob, const f32x2* __restrict__ rope, char* lds) {
  const int tid = threadIdx.x, wid = tid >> 6, lane = tid & 63, r32 = lane & 31, hi = lane >> 5;
  char* V_lds = lds; char* K_lds = lds + 2 * SHM_V;
  float* wsf = (float*)(lds + 2 * SHM_V + 2 * SHM_K) + wid * 64; float* li_l = wsf; float* al_l = wsf + 32;
  float m_reg = -1e30f, l_reg = 0; f32x16 o[4] = {}; bf16x8 qr[12];
  { const bf16* Qw = Qb + (size_t)(wid * QBLK + r32) * NQ + hi * 8;
#pragma unroll
    for (int d0 = 0; d0 < 8; ++d0) qr[d0] = *reinterpret_cast<const bf16x8*>(Qw + d0 * 16);
    const f32x2* rp = rope + (size_t)(wid * QBLK + r32) * 32 + hi * 8;
#pragma unroll
    for (int pp = 0; pp < 2; ++pp) {
      const v4u wa = *reinterpret_cast<const v4u*>(Qw + 128 + 16 * pp), wb = *reinterpret_cast<const v4u*>(Qw + 128 + 32 + 16 * pp);
      const unsigned a[4] = {wa.x, wa.y, wa.z, wa.w}, b[4] = {wb.x, wb.y, wb.z, wb.w}; unsigned oa[4], ob[4];
#pragma unroll
      for (int k = 0; k < 4; ++k) { const f32x2 cs0 = rp[16 * pp + 2 * k], cs1 = rp[16 * pp + 2 * k + 1];
        const float x0 = bflo(a[k]), x1 = bfhi(a[k]), y0 = bflo(b[k]), y1 = bfhi(b[k]);
        oa[k] = cvtpk(x0 * cs0.x - y0 * cs0.y, x1 * cs1.x - y1 * cs1.y);
        ob[k] = cvtpk(y0 * cs0.x + x0 * cs0.y, y1 * cs1.x + x1 * cs1.y); }
      qr[8 + pp] = __builtin_bit_cast(bf16x8, (v4u){oa[0], oa[1], oa[2], oa[3]}); qr[10 + pp] = __builtin_bit_cast(bf16x8, (v4u){ob[0], ob[1], ob[2], ob[3]}); }
  }
  const int sr = tid >> 4, sc = (tid & 15) * 8, vst0 = v_st(sr, sc), vst1 = v_st(32 + sr, sc);
  const int pr = tid >> 3, pc = (tid & 7) * 8;
  const int vb0 = (int)(uintptr_t)V_lds + v_rd_base(lane);
  const bf16* gkv = KVh + (size_t)sr * NKV + sc; const bf16* gkp = KPb + (size_t)pr * DROPE + pc;
  const int kst0 = KSWZ(sr, sc * 2), kst1 = KSWZ(32 + sr, sc * 2), kst2 = KSWZ(pr, 256 + pc * 2);
  bf16x8 vs0, vs1, ks0, ks1, ks2;
#define SLOAD(k0) do { const bf16* g_ = gkv + (size_t)(k0) * NKV; ks0 = *reinterpret_cast<const bf16x8*>(g_); vs0 = *reinterpret_cast<const bf16x8*>(g_ + 128); \
    ks1 = *reinterpret_cast<const bf16x8*>(g_ + 32 * NKV); vs1 = *reinterpret_cast<const bf16x8*>(g_ + 32 * NKV + 128); ks2 = *reinterpret_cast<const bf16x8*>(gkp + (size_t)(k0) * DROPE); } while (0)
#define SWRITE(b) do { *(bf16x8*)(V_lds + (b) * SHM_V + vst0) = vs0; *(bf16x8*)(V_lds + (b) * SHM_V + vst1) = vs1; \
    *(bf16x8*)(K_lds + (b) * SHM_K + kst0) = ks0; *(bf16x8*)(K_lds + (b) * SHM_K + kst1) = ks1; *(bf16x8*)(K_lds + (b) * SHM_K + kst2) = ks2; } while (0)
#define SWAIT() asm volatile("s_waitcnt vmcnt(0)" ::: "memory")
#define RESC(a) do { if (__any((a) < 1.f)) { if (hi == 0) al_l[r32] = (a); asm volatile("s_waitcnt lgkmcnt(0)" ::: "memory"); \
    _Pragma("unroll") for (int d = 0; d < 4; ++d) _Pragma("unroll") for (int r = 0; r < 16; ++r) o[d][r] *= al_l[crow(r, hi)]; } } while (0)
  f32x16 p0, p1; float mn, al; bf16x8 pa0, pa1, pa2, pa3; constexpr int NT = SEQ / KVBLK;
  SLOAD(0); SWAIT(); SWRITE(0); __syncthreads();
  for (int j = 0; j < NT; ++j) {
    const int bsel = j & 1;
    SBAR(); qkt(p0, p1, K_lds + bsel * SHM_K, qr, r32, hi); SBAR();
    if (j + 1 < NT) SLOAD((j + 1) * KVBLK);
    SBAR();
    partialSM(p0, p1, m_reg, mn, al); RESC(al);
    finishSM(p0, p1, al, l_reg, pa0, pa1, pa2, pa3); SBAR();
    pv_d0(o, vb0 + bsel * SHM_V, pa0, pa1, pa2, pa3);
    if (j + 1 < NT) { SWAIT(); SWRITE(bsel ^ 1); }
    __syncthreads();
  }
  if (hi == 0) li_l[r32] = l_reg; asm volatile("s_waitcnt lgkmcnt(0)" ::: "memory");
  float rli[16];
#pragma unroll
  for (int r = 0; r < 16; ++r) rli[r] = __builtin_amdgcn_rcpf(li_l[crow(r, hi)]);
  bf16* Ow = Ob + (size_t)(wid * QBLK) * AW;
#pragma unroll
  for (int r = 0; r < 16; ++r) { int orow = crow(r, hi);
#pragma unroll
    for (int d0 = 0; d0 < 4; ++d0) Ow[(size_t)orow * AW + d0 * 32 + r32] = (bf16)f2bf(o[d0][r] * rli[r]); }
  __syncthreads();
#undef SLOAD
#undef SWRITE
#undef SWAIT
#undef RESC
}
}

__device__ __forceinline__ void p5_attention(Frame& F) {
    const bf16* Q = (const bf16*)(F.ws + WS_Q); const bf16* KV = (const bf16*)(F.ws + WS_KV); const bf16* KPE = (const bf16*)(F.ws + WS_KPE); bf16* O = (bf16*)(F.ws + WS_O);
    const f32x2* ROPE = (const f32x2*)(F.ws + WS_ROPE);
    for (int unit = F.vcu; unit < BATCH * NH * 8; unit += F.G) {
        const int qb = unit & 7, bh = unit >> 3, b = bh >> 3, h = bh & 7; const size_t m0 = (size_t)b * SEQ + qb * 256;
        att::attn_unit(Q + m0 * NQ + h * DQK, KV + (size_t)b * SEQ * NKV + h * 256, KPE + (size_t)b * SEQ * DROPE, O + m0 * AW + h * DV, ROPE + qb * 256 * 32, F.ldsg);
    }
}

__device__ __forceinline__ void p6_mixnorm(Frame& F) {
    const bf16* O = (const bf16*)(F.ws + WS_O); const bf16* YT = (const bf16*)(F.ws + WS_YT); bf16* MIXIN = (bf16*)(F.ws + WS_MIXIN);
    const float* gh = F.in[17]; const float* ga = F.in[18];
    const int gw = F.vcu * NWAVES + F.wave, NGW = F.G * NWAVES, lane = F.lane, tid = F.tid;
    for (int m0 = gw; m0 < M; m0 += NGW * 2) {
        v4u w[2][2];
#pragma unroll
        for (int u = 0; u < 2; ++u)
#pragma unroll
            for (int j = 0; j < 2; ++j) w[u][j] = __builtin_nontemporal_load((const v4u*)(O + (size_t)(m0 + u * NGW) * AW + 8 * (lane + 64 * j)));
#pragma unroll
        for (int u = 0; u < 2; ++u) { const int m = m0 + u * NGW; float s = 0.f;
#pragma unroll
            for (int j = 0; j < 2; ++j) { const unsigned a[4] = {w[u][j].x, w[u][j].y, w[u][j].z, w[u][j].w};
#pragma unroll
                for (int k = 0; k < 4; ++k) { const float x0 = bflo(a[k]), x1 = bfhi(a[k]); s += x0 * x0 + x1 * x1; } }
            const float r = 1.f / sqrtf(wave_sum(s) * (1.f / AW) + EPS);
#pragma unroll
            for (int j = 0; j < 2; ++j) { const int c = 8 * (lane + 64 * j); const unsigned a[4] = {w[u][j].x, w[u][j].y, w[u][j].z, w[u][j].w}; unsigned o[4];
                const f32x4 g0 = *(const f32x4*)(ga + c), g1 = *(const f32x4*)(ga + c + 4); const float g[8] = {g0.x, g0.y, g0.z, g0.w, g1.x, g1.y, g1.z, g1.w};
#pragma unroll
                for (int k = 0; k < 4; ++k) o[k] = pk2(bflo(a[k]) * r * g[2 * k], bfhi(a[k]) * r * g[2 * k + 1]);
                *(v4u*)(MIXIN + (size_t)m * DM + HW + c) = (v4u){o[0], o[1], o[2], o[3]}; } }
    }
    LAS bf16* T = (LAS bf16*)F.lds; constexpr int TP = 1026;
    for (int unit = F.vcu; unit < BATCH * 64; unit += F.G) {
        const int b = unit >> 6, s0 = (unit & 63) * 32;
        __syncthreads();
#pragma unroll
        for (int i = 0; i < 8; ++i) { const int ch = tid & 3, c = (tid >> 2) + 128 * i;
            const v4u w = __builtin_nontemporal_load((const v4u*)(YT + ((size_t)c * BATCH + b) * SEQ + s0 + ch * 8)); const unsigned a[4] = {w.x, w.y, w.z, w.w};
#pragma unroll
            for (int k = 0; k < 4; ++k) { T[(ch * 8 + 2 * k) * TP + c] = (bf16)(a[k] & 0xffffu); T[(ch * 8 + 2 * k + 1) * TP + c] = (bf16)(a[k] >> 16); } }
        __syncthreads();
#pragma unroll
        for (int q = 0; q < 4; ++q) { const int sl = F.wave * 4 + q; unsigned v[8]; float s = 0.f;
#pragma unroll
            for (int k = 0; k < 8; ++k) { v[k] = *(const LAS unsigned*)(T + sl * TP + 2 * lane + 128 * k); const float x0 = bflo(v[k]), x1 = bfhi(v[k]); s += x0 * x0 + x1 * x1; }
            const float r = 1.f / sqrtf(wave_sum(s) * (1.f / HW) + EPS);
            bf16* orow = MIXIN + ((size_t)b * SEQ + s0 + sl) * DM;
#pragma unroll
            for (int k = 0; k < 8; ++k) { const int c = 2 * lane + 128 * k; const f32x2 g = *(const f32x2*)(gh + c);
                *(unsigned*)(orow + c) = pk2(bflo(v[k]) * r * g.x, bfhi(v[k]) * r * g.y); } }
    }
    __syncthreads();
}

__device__ __forceinline__ void p8_postmix(Frame& F) {
    const bf16* MIXED = (const bf16*)(F.ws + WS_MIXED); bf16* XN = (bf16*)(F.ws + WS_XN);
    const float* x = F.in[0]; const float* gpost = F.in[20]; const float* gpre = F.in[21]; bf16* H16 = (bf16*)(F.ws + WS_H16);
    const int gw = F.vcu * NWAVES + F.wave, NGW = F.G * NWAVES, lane = F.lane;
    for (int m = gw; m < M; m += NGW) {
        float mx[32]; float s = 0.f;
#pragma unroll
        for (int j = 0; j < 4; ++j) { const v4u w = *(const v4u*)(MIXED + (size_t)m * DM + 8 * (lane + 64 * j)); const unsigned a[4] = {w.x, w.y, w.z, w.w};
#pragma unroll
            for (int k = 0; k < 4; ++k) { mx[8 * j + 2 * k] = bflo(a[k]); mx[8 * j + 2 * k + 1] = bfhi(a[k]); s += mx[8 * j + 2 * k] * mx[8 * j + 2 * k] + mx[8 * j + 2 * k + 1] * mx[8 * j + 2 * k + 1]; } }
        const float r = 1.f / sqrtf(wave_sum(s) * (1.f / DM) + EPS);
        float s2 = 0.f;
#pragma unroll
        for (int j = 0; j < 4; ++j) { const int c = 8 * (lane + 64 * j);
#pragma unroll
            for (int hh = 0; hh < 2; ++hh) { const f32x4 xv = *(const f32x4*)(x + (size_t)m * DM + c + 4 * hh); const f32x4 g = *(const f32x4*)(gpost + c + 4 * hh);
                f32x4 hv; hv.x = xv.x + mx[8 * j + 4 * hh] * r * g.x; hv.y = xv.y + mx[8 * j + 4 * hh + 1] * r * g.y; hv.z = xv.z + mx[8 * j + 4 * hh + 2] * r * g.z; hv.w = xv.w + mx[8 * j + 4 * hh + 3] * r * g.w;
                mx[8 * j + 4 * hh] = hv.x; mx[8 * j + 4 * hh + 1] = hv.y; mx[8 * j + 4 * hh + 2] = hv.z; mx[8 * j + 4 * hh + 3] = hv.w;
                s2 += (hv.x * hv.x + hv.y * hv.y) + (hv.z * hv.z + hv.w * hv.w); } }
        const float s2t = wave_sum(s2); if (lane == 0) ((float*)(F.ws + WS_SS2))[m] = s2t;
        const float r2 = 1.f / sqrtf(s2t * (1.f / DM) + EPS);
#pragma unroll
        for (int j = 0; j < 4; ++j) { const int c = 8 * (lane + 64 * j); const f32x4 g0 = *(const f32x4*)(gpre + c), g1 = *(const f32x4*)(gpre + c + 4);
            { v4u hq; hq.x = pk2(mx[8 * j], mx[8 * j + 1]); hq.y = pk2(mx[8 * j + 2], mx[8 * j + 3]); hq.z = pk2(mx[8 * j + 4], mx[8 * j + 5]); hq.w = pk2(mx[8 * j + 6], mx[8 * j + 7]);
              *(v4u*)(H16 + (size_t)m * DM + c) = hq; }
            v4u o; o.x = pk2(mx[8 * j] * r2 * g0.x, mx[8 * j + 1] * r2 * g0.y); o.y = pk2(mx[8 * j + 2] * r2 * g0.z, mx[8 * j + 3] * r2 * g0.w);
            o.z = pk2(mx[8 * j + 4] * r2 * g1.x, mx[8 * j + 5] * r2 * g1.y); o.w = pk2(mx[8 * j + 6] * r2 * g1.z, mx[8 * j + 7] * r2 * g1.w);
            *(v4u*)(XN + (size_t)m * DM + c) = o; }
    }
}
__device__ __forceinline__ void p10_fixup(Frame& F) {
    const f32x4* BB = (const f32x4*)(F.ws + WS_BB); bf16* ACT = (bf16*)(F.ws + WS_ACT);
    const float* cw = F.in[23];
    constexpr int UB = 8, NE = 512 * DFF;
    const int stride = F.G * NTHR;
    for (int i0 = F.vcu * NTHR + F.tid; i0 < NE; i0 += stride * UB) {
        f32x4 v[UB]; float gn[UB], wn[UB]; int rr[UB], cc[UB]; bool ok[UB];
#pragma unroll
        for (int u = 0; u < UB; ++u) { int i = i0 + u * stride; ok[u] = (i < NE); i = ok[u] ? i : i0;
            const int q = i / DFF, c = i - q * DFF, chunk = q >> 1, last = q & 1; const int r = chunk * 64 + (last ? 63 : 0);
            const bool un = last ? (((r + 1) & (SEQ - 1)) != 0) : ((r & (SEQ - 1)) != 0);
            const int ni = un ? (last ? i + DFF : i - DFF) : i;
            v[u] = BB[i]; gn[u] = un ? BB[ni].y : 0.f; wn[u] = cw[(last ? 2 * DFF : 0) + c]; rr[u] = r; cc[u] = c; }
#pragma unroll
        for (int u = 0; u < UB; ++u) { const float pre = v[u].x + wn[u] * gn[u];
            if (ok[u]) ACT[(size_t)rr[u] * DFF + cc[u]] = (bf16)f2bf(pg8::gelu_tanh(pre) * v[u].z); }
    }
}
__device__ __forceinline__ void p12_final(Frame& F) {
    const bf16* FB = (const bf16*)(F.ws + WS_F); const bf16* H16 = (const bf16*)(F.ws + WS_H16); const float* g = F.in[26]; float* out = F.out;
    const int gw = F.vcu * NWAVES + F.wave, NGW = F.G * NWAVES, lane = F.lane;
    for (int m = gw; m < M; m += NGW) {
        float fx[32]; float s = 0.f; v4u hw[4];
#pragma unroll
        for (int j = 0; j < 4; ++j) { const v4u w = *(const v4u*)(FB + (size_t)m * DM + 8 * (lane + 64 * j)); hw[j] = *(const v4u*)(H16 + (size_t)m * DM + 8 * (lane + 64 * j)); const unsigned a[4] = {w.x, w.y, w.z, w.w};
#pragma unroll
            for (int k = 0; k < 4; ++k) { fx[8 * j + 2 * k] = bflo(a[k]); fx[8 * j + 2 * k + 1] = bfhi(a[k]); s += fx[8 * j + 2 * k] * fx[8 * j + 2 * k] + fx[8 * j + 2 * k + 1] * fx[8 * j + 2 * k + 1]; } }
        const float r = 1.f / sqrtf(wave_sum(s) * (1.f / DM) + EPS);
#pragma unroll
        for (int j = 0; j < 4; ++j) { const int c = 8 * (lane + 64 * j); const unsigned hh4[4] = {hw[j].x, hw[j].y, hw[j].z, hw[j].w};
#pragma unroll
            for (int hh = 0; hh < 2; ++hh) { float* p = out + (size_t)m * DM + c + 4 * hh; const f32x4 gg = *(const f32x4*)(g + c + 4 * hh);
                f32x4 ov; ov.x = bflo(hh4[2 * hh]) + fx[8 * j + 4 * hh] * r * gg.x; ov.y = bfhi(hh4[2 * hh]) + fx[8 * j + 4 * hh + 1] * r * gg.y;
                ov.z = bflo(hh4[2 * hh + 1]) + fx[8 * j + 4 * hh + 2] * r * gg.z; ov.w = bfhi(hh4[2 * hh + 1]) + fx[8 * j + 4 * hh + 3] * r * gg.w;
                *(f32x4*)p = ov; } }
    }
}

struct Args { const float* in[27]; float* out; unsigned char* ws; int ph_lo, ph_hi; };
template <bool COOP>
__global__ void __launch_bounds__(NTHR, 2) mk_fwd(Args args) {
    extern __shared__ __attribute__((aligned(16))) unsigned char lds[];
    Frame F;
    F.lds = (LAS unsigned char*)lds; F.ldsg = (char*)lds;
    F.tid = threadIdx.x; F.lane = F.tid & 63; F.wave = __builtin_amdgcn_readfirstlane(F.tid >> 6);
    F.G = gridDim.x; { const int bx = blockIdx.x; F.vcu = (F.G % 8 == 0) ? (bx % 8) * (F.G / 8) + bx / 8 : bx; }
#pragma unroll
    for (int i = 0; i < 27; ++i) F.in[i] = args.in[i];
    F.out = args.out; F.ws = args.ws;
    unsigned char* ws = args.ws;
    const int lo = args.ph_lo, hi = args.ph_hi;
    volatile LAS unsigned* MISC = (volatile LAS unsigned*)(F.lds + 131072 + 320);
    XcdBarrier bar; bar.bar = (unsigned*)ws; bar.x = 0; bar.st = nullptr;
    if (COOP) { if (F.tid < 32) MISC[F.tid] = 0u; __syncthreads(); bar = xcd_barrier_post((unsigned*)ws, MISC + 8);
        p0_pre(F);
        if (F.G != 256) cg::this_grid().sync(); }
#ifndef PROBE_REP
#define PROBE_REP 0
#endif
#define REP(k) for (int rep_ = 0; rep_ < 1 + ((PROBE_REP >> (k)) & 1); ++rep_)
#define IN(k) (lo <= (k) && (k) < hi)
#define SEAM(k) do { if (COOP && IN((k) + 1)) xcd_barrier(bar); } while (0)
#ifndef SKIP_P0
    if (IN(0)) { REP(0) p0_prologue(F); SEAM(0); }
#endif
    if (IN(1)) { pg8::Gemm g{(const bf16*)(ws + WS_XN), (const bf16*)(ws + WS_WIN), M, INWP, DM}; pg8::StaticOrder S; S.init(M, INWP, F.G, (int)blockIdx.x);
        pg8::EpiStore E{(bf16*)(ws + WS_PROJ), INWP};
        pg8::gemm_phase<pg8::EpiStore, pg8::StaticOrder, true, true>(F.lds, g, S, E); SEAM(1); }
    if (IN(2)) { REP(2) { p2_hyena_prep(F); p2_mla_prep(F); p2_filter_out(F); } SEAM(2); }
    if (IN(3)) {
#ifndef SKIP_LC
        REP(3) p4_longconv(F);
#endif
        { pg8::Gemm g{(const bf16*)(ws + WS_CQN), (const bf16*)(ws + WS_WUQ), M, NQ, QLR}; pg8::StaticOrder S; S.init(M, NQ, F.G, (int)blockIdx.x);
          pg8::EpiStore E{(bf16*)(ws + WS_Q), NQ};
          pg8::gemm_phase<pg8::EpiStore, pg8::StaticOrder, true, true>(F.lds, g, S, E); }
        { pg8::Gemm g{(const bf16*)(ws + WS_CKVN), (const bf16*)(ws + WS_WUKV), M, NKV, KVLR}; pg8::StaticOrder S; S.init(M, NKV, F.G, (int)blockIdx.x);
          pg8::EpiStore E{(bf16*)(ws + WS_KV), NKV};
          pg8::gemm_phase<pg8::EpiStore, pg8::StaticOrder, true, true>(F.lds, g, S, E); }
        SEAM(3); }
    #ifndef SKIP_ATT
    if (IN(4)) { REP(4) p5_attention(F); SEAM(4); }
#endif
    if (IN(5)) { REP(5) p6_mixnorm(F); SEAM(5); }
    const bool fused = (F.G == 256);
    if (IN(6)) { pg8::Gemm g{(const bf16*)(ws + WS_MIXIN), (const bf16*)(ws + WS_WOUT), M, DM, DM}; pg8::StaticOrder S; S.init(M, DM, F.G, (int)blockIdx.x);
        if (fused) { pg8::EpiMixRes E{(bf16*)(ws + WS_MIXED), F.in[0], F.in[20], (bf16*)(ws + WS_H16), (float*)(ws + WS_SS1), (float*)(ws + WS_SS2), (unsigned*)(ws + WS_CNT), DM, EPS};
            pg8::gemm_phase<pg8::EpiMixRes, pg8::StaticOrder, true, true>(F.lds, g, S, E); }
        else { pg8::EpiStore E{(bf16*)(ws + WS_MIXED), DM};
            pg8::gemm_phase<pg8::EpiStore, pg8::StaticOrder, true, true>(F.lds, g, S, E); if (COOP) xcd_barrier(bar); p8_postmix(F); }
        SEAM(7); }
#ifndef SKIP_GEGLU
    if (IN(8)) { pg8::Gemm g{(const bf16*)(ws + WS_H16), (const bf16*)(ws + WS_WUP), M, 2 * DFF, DM}; pg8::StaticOrder S; S.init(M, 2 * DFF, F.G, (int)blockIdx.x);
        pg8::EpiGeglu E{(bf16*)(ws + WS_ACT), F.in[23], F.in[24], (pg8::f32x4*)(ws + WS_BB), DFF, (const float*)(ws + WS_SS2), EPS};
        pg8::gemm_phase<pg8::EpiGeglu, pg8::StaticOrder, true, true>(F.lds, g, S, E); SEAM(8); }
#endif
    if (IN(9)) { REP(9) p10_fixup(F); SEAM(9); }
    if (IN(10)) { pg8::Gemm g{(const bf16*)(ws + WS_ACT), (const bf16*)(ws + WS_WDOWN), M, DM, DFF}; pg8::StaticOrder S; S.init(M, DM, F.G, (int)blockIdx.x);
        if (fused) { pg8::EpiFinal E{(bf16*)(ws + WS_F), (const bf16*)(ws + WS_H16), F.in[26], F.out, (float*)(ws + WS_SS3), (unsigned*)(ws + WS_CNT2), DM, EPS};
            pg8::gemm_phase<pg8::EpiFinal, pg8::StaticOrder, true, true>(F.lds, g, S, E); }
        else { pg8::EpiStore E{(bf16*)(ws + WS_F), DM};
            pg8::gemm_phase<pg8::EpiStore, pg8::StaticOrder, true, true>(F.lds, g, S, E); if (COOP) xcd_barrier(bar); p12_final(F); } }
#undef IN
#undef SEAM
}

extern "C" void kernel_launch(void* const* d_in, const int* in_sizes, int n_in, void* d_out, int out_size, void* d_ws, size_t ws_size, hipStream_t stream) {
    static int grid = 0;
    if (grid == 0) {
        if (n_in != 27 || in_sizes[0] != M * DM || out_size != M * DM || ws_size < WS_END) { fprintf(stderr, "kernel_launch: unexpected shapes: n_in %d in0 %d out %d ws %zu (need %zu)\n", n_in, n_in > 0 ? in_sizes[0] : -1, out_size, ws_size, (size_t)WS_END); grid = -1; return; }
        int dev = 0, cus = 0;
        if (hipGetDevice(&dev) != hipSuccess || hipDeviceGetAttribute(&cus, hipDeviceAttributeMultiprocessorCount, dev) != hipSuccess) { grid = -1; return; }
        if (hipFuncSetAttribute((const void*)mk_fwd<true>, hipFuncAttributeMaxDynamicSharedMemorySize, LDS_BYTES) != hipSuccess ||
            hipFuncSetAttribute((const void*)mk_fwd<false>, hipFuncAttributeMaxDynamicSharedMemorySize, LDS_BYTES) != hipSuccess) { fprintf(stderr, "kernel_launch: hipFuncSetAttribute failed\n"); grid = -1; return; }
        int per_cu = 0;
        if (hipOccupancyMaxActiveBlocksPerMultiprocessor(&per_cu, (const void*)mk_fwd<true>, NTHR, LDS_BYTES) != hipSuccess || per_cu < 1) { fprintf(stderr, "kernel_launch: occupancy query says %d\n", per_cu); }
        (void)hipGetLastError();
        grid = cus;
    }
    if (grid < 0) return;
    Args a{};
    for (int i = 0; i < 27; ++i) a.in[i] = (const float*)d_in[i];
    a.out = (float*)d_out; a.ws = (unsigned char*)d_ws;
    if (MK_N_LAUNCHES == 1) {
        a.ph_lo = 0; a.ph_hi = 12;
        if (hipMemsetAsync(d_ws, 0, CTL_BYTES, stream) != hipSuccess) { fprintf(stderr, "kernel_launch: memset failed\n"); return; }
        void* kargs[] = {&a};
        hipError_t e = hipLaunchCooperativeKernel((const void*)mk_fwd<true>, dim3(grid), dim3(NTHR), kargs, LDS_BYTES, stream);
        if (e != hipSuccess) fprintf(stderr, "kernel_launch: cooperative launch failed: %s (grid %d)\n", hipGetErrorString(e), grid);
    } else {
        for (int p = 0; p < 12; ++p) { a.ph_lo = p; a.ph_hi = p + 1;
            hipLaunchKernelGGL(mk_fwd<false>, dim3(grid), dim3(NTHR), LDS_BYTES, stream, a);
            const hipError_t le = hipPeekAtLastError();
            if (le != hipSuccess) { fprintf(stderr, "kernel_launch: launch %d failed: %s\n", p, hipGetErrorName(le)); break; } }
    }
}
```
